# Optimizing an MI355X kernel written in HIP

```python
import jax, jax.numpy as jnp
from jax import lax
import numpy as np

D_MODEL = 1024
BATCH = 8
SEQ = 2048
DEPTH = 4

HEAD_DIM = 64
N_HEADS = D_MODEL // HEAD_DIM
INNER = N_HEADS * HEAD_DIM
ROT_DIM = HEAD_DIM // 4
ROPE_THETA = 500000.0
DSWA_GROUPS = ((128, 1), (512, 4), (2048, 16))
N_GROUPS = len(DSWA_GROUPS)
BLOCK = 128
N_MIXERS = 2
EPS = 1e-6
FOX_IN = 4 * INNER + N_HEADS
DSW_IN = 3 * N_GROUPS * INNER + INNER

kernel_name = "fox_dilated_swa_gated_hybrid"


def rms_norm(x, g):
    xf = x.astype(jnp.float32)
    y = xf * lax.rsqrt(jnp.mean(xf * xf, axis=-1, keepdims=True) + EPS) * g.astype(jnp.float32)
    return y.astype(x.dtype)


def rotary_tables(positions):
    inv_freq = ROPE_THETA ** (-jnp.arange(0, ROT_DIM, 2, dtype=jnp.float32) / ROT_DIM)
    ang = positions.astype(jnp.float32)[..., None] * inv_freq
    return jnp.cos(ang), jnp.sin(ang)


def apply_partial_rotary(t, cos, sin):
    half = ROT_DIM // 2
    c = cos[:, :, None, None, :].astype(t.dtype)
    s = sin[:, :, None, None, :].astype(t.dtype)
    t1, t2, rest = t[..., :half], t[..., half:ROT_DIM], t[..., ROT_DIM:]
    return jnp.concatenate([t1 * c - t2 * s, t2 * c + t1 * s, rest], axis=-1)


def fox_attention(q, k, v, c):
    B, S, H, dh = q.shape
    nq = S // BLOCK
    scale = dh ** -0.5
    qb = q.reshape(B, nq, BLOCK, H, dh).transpose(1, 0, 2, 3, 4)
    cb = c.reshape(B, nq, BLOCK, H).transpose(1, 0, 3, 2)
    c_k = c.transpose(0, 2, 1)
    key_pos = jnp.arange(S)

    def one_block(args):
        qi, ci, bi = args
        s = jnp.einsum('bqhd,bkhd->bhqk', qi, k).astype(jnp.float32) * scale
        s = s + ci[..., None] - c_k[:, :, None, :]
        q_pos = bi * BLOCK + jnp.arange(BLOCK)
        mask = key_pos[None, :] <= q_pos[:, None]
        s = jnp.where(mask, s, -jnp.inf)
        p = jax.nn.softmax(s, axis=-1).astype(v.dtype)
        return jnp.einsum('bhqk,bkhd->bqhd', p, v)

    o = lax.map(one_block, (qb, cb, jnp.arange(nq)))
    return o.transpose(1, 0, 2, 3, 4).reshape(B, S, H, dh)


def fox_mixer(h, w_in, b_f, q_g, k_g):
    B, S, _ = h.shape
    proj = h @ w_in
    q = rms_norm(proj[..., :INNER].reshape(B, S, N_HEADS, HEAD_DIM), q_g)
    k = rms_norm(proj[..., INNER:2 * INNER].reshape(B, S, N_HEADS, HEAD_DIM), k_g)
    v = proj[..., 2 * INNER:3 * INNER].reshape(B, S, N_HEADS, HEAD_DIM)
    gate = proj[..., 3 * INNER:4 * INNER]
    f_logit = proj[..., 4 * INNER:].astype(jnp.float32) + b_f.astype(jnp.float32)
    c = jnp.cumsum(jax.nn.log_sigmoid(f_logit), axis=1)
    o = fox_attention(q, k, v, c)
    return o.reshape(B, S, INNER), gate


def _band(t):
    prev = jnp.concatenate([jnp.zeros_like(t[:, :1]), t[:, :-1]], axis=1)
    return jnp.concatenate([prev, t], axis=2)


def dilated_window_attention(q, k, v, window, dilation):
    B, S, H, dh = q.shape
    r = dilation
    L = S // r
    n_back = window // r
    nb = -(-L // BLOCK)
    Lp = nb * BLOCK
    scale = dh ** -0.5

    def to_blocks(t):
        t = t.reshape(B, L, r, H, dh).transpose(0, 2, 1, 3, 4).reshape(B * r, L, H, dh)
        t = jnp.pad(t, ((0, 0), (0, Lp - L), (0, 0), (0, 0)))
        return t.reshape(B * r, nb, BLOCK, H, dh)

    qb, kb, vb = to_blocks(q), to_blocks(k), to_blocks(v)
    s = jnp.einsum('znqhd,znkhd->znhqk', qb, _band(kb)).astype(jnp.float32) * scale
    q_idx = jnp.arange(nb)[:, None] * BLOCK + jnp.arange(BLOCK)[None, :]
    k_idx = jnp.arange(nb)[:, None] * BLOCK - BLOCK + jnp.arange(2 * BLOCK)[None, :]
    dist = q_idx[:, :, None] - k_idx[:, None, :]
    mask = (dist >= 0) & (dist <= n_back) & (k_idx[:, None, :] >= 0)
    s = jnp.where(mask[None, :, None], s, -jnp.inf)
    lse = jax.nn.logsumexp(s, axis=-1)
    p = jnp.exp(s - lse[..., None]).astype(v.dtype)
    o = jnp.einsum('znhqk,znkhd->znqhd', p, _band(vb))
    o = o.reshape(B * r, Lp, H, dh)[:, :L]
    o = o.reshape(B, r, L, H, dh).transpose(0, 2, 1, 3, 4).reshape(B, S, H, dh)
    lse = lse.transpose(0, 1, 3, 2).reshape(B * r, Lp, H)[:, :L]
    lse = lse.reshape(B, r, L, H).transpose(0, 2, 1, 3).reshape(B, S, H)
    return o, lse


def dsw_mixer(h, cos, sin, w_in, q_g, k_g):
    B, S, _ = h.shape
    proj = h @ w_in
    qkv = proj[..., :3 * N_GROUPS * INNER].reshape(B, S, 3, N_GROUPS, N_HEADS, HEAD_DIM)
    gate = proj[..., 3 * N_GROUPS * INNER:]
    q = apply_partial_rotary(rms_norm(qkv[:, :, 0], q_g[:, None, :]), cos, sin)
    k = apply_partial_rotary(rms_norm(qkv[:, :, 1], k_g[:, None, :]), cos, sin)
    v = qkv[:, :, 2]
    outs, lses = [], []
    for g, (window, dilation) in enumerate(DSWA_GROUPS):
        o_g, lse_g = dilated_window_attention(q[:, :, g], k[:, :, g], v[:, :, g], window, dilation)
        outs.append(o_g)
        lses.append(lse_g)
    wts = jax.nn.softmax(jnp.stack(lses, axis=0), axis=0).astype(v.dtype)
    o = jnp.einsum('gbsh,gbshd->bshd', wts, jnp.stack(outs, axis=0))
    return o.reshape(B, S, INNER), gate


def setup_inputs(seed: int = 0) -> dict:
    key = jax.random.key(seed)
    ks = jax.random.split(key, 13)
    n_fox = (DEPTH + 1) // N_MIXERS
    n_dsw = DEPTH // N_MIXERS
    f32 = jnp.float32
    x = jax.random.normal(ks[0], (BATCH, SEQ, D_MODEL), f32)
    offset = jax.random.randint(ks[1], (BATCH, 1), 0, 4096, dtype=jnp.int32)
    positions = offset + jnp.arange(SEQ, dtype=jnp.int32)[None, :]
    norm_g = 1.0 + 0.02 * jax.random.normal(ks[2], (DEPTH, D_MODEL), f32)
    fox_w_in = jax.random.normal(ks[3], (n_fox, D_MODEL, FOX_IN), f32) * D_MODEL ** -0.5
    fox_b_f = jax.random.uniform(ks[4], (n_fox, N_HEADS), f32, minval=1.0, maxval=4.0)
    fox_q_norm = 1.0 + 0.02 * jax.random.normal(ks[5], (n_fox, HEAD_DIM), f32)
    fox_k_norm = 1.0 + 0.02 * jax.random.normal(ks[6], (n_fox, HEAD_DIM), f32)
    fox_w_out = jax.random.normal(ks[7], (n_fox, INNER, D_MODEL), f32) * (2 * INNER) ** -0.5
    dsw_w_in = jax.random.normal(ks[8], (n_dsw, D_MODEL, DSW_IN), f32) * D_MODEL ** -0.5
    dsw_q_norm = 1.0 + 0.02 * jax.random.normal(ks[9], (n_dsw, N_GROUPS, HEAD_DIM), f32)
    dsw_k_norm = 1.0 + 0.02 * jax.random.normal(ks[10], (n_dsw, N_GROUPS, HEAD_DIM), f32)
    dsw_w_out = jax.random.normal(ks[11], (n_dsw, INNER, D_MODEL), f32) * (2 * INNER) ** -0.5
    return {"x": x, "positions": positions, "norm_g": norm_g,
            "fox_w_in": fox_w_in, "fox_b_f": fox_b_f, "fox_q_norm": fox_q_norm,
            "fox_k_norm": fox_k_norm, "fox_w_out": fox_w_out,
            "dsw_w_in": dsw_w_in, "dsw_q_norm": dsw_q_norm, "dsw_k_norm": dsw_k_norm,
            "dsw_w_out": dsw_w_out}


def reference(x, positions, norm_g, fox_w_in, fox_b_f, fox_q_norm, fox_k_norm, fox_w_out,
              dsw_w_in, dsw_q_norm, dsw_k_norm, dsw_w_out):
    cos, sin = rotary_tables(positions)
    for i in range(DEPTH):
        j = i // N_MIXERS
        h = rms_norm(x, norm_g[i])
        if i % N_MIXERS == 0:
            o, gate = fox_mixer(h, fox_w_in[j], fox_b_f[j], fox_q_norm[j], fox_k_norm[j])
            w_out = fox_w_out[j]
        else:
            o, gate = dsw_mixer(h, cos, sin, dsw_w_in[j], dsw_q_norm[j], dsw_k_norm[j])
            w_out = dsw_w_out[j]
        x = x + (o * jax.nn.silu(gate)) @ w_out
    return x
```

```cpp
#include <hip/hip_runtime.h>
#include <hip/hip_cooperative_groups.h>
#include <cstdio>
#include <cstdint>
namespace cg = cooperative_groups;
#define REP_PRO 1
#define REP_FG 1
#define REP_PROJ 1
#define REP_FOX 1
#define REP_DSW 1
#define REP_SYNC 1
__device__ __forceinline__ int mk_tid() { int t = threadIdx.x; asm volatile("" : "+v"(t)); return t; }
namespace pg8 {
#define PG8_LAS __attribute__((address_space(3)))
typedef unsigned short bf16_t;
typedef short bf16x8 __attribute__((ext_vector_type(8)));
typedef float f32x4 __attribute__((ext_vector_type(4)));
typedef unsigned u32x4 __attribute__((ext_vector_type(4)));
constexpr int BM = 256, BK = 64, HALF = 128, HTB = HALF * BK * 2  , STAGE_BYTES = 8 * HTB, NXCD = 8, WGM = 8;

__host__ __device__ __forceinline__ int lds_byte(int r, int c) { const int st = (r >> 4) * 2 + (c >> 5), rr = r & 15, cc = c & 31, ob = rr * 64 + cc * 2; return st * 1024 + (ob ^ (((ob >> 9) & 1) << 5)); }
__host__ __device__ __forceinline__ void stage_rc(int b, int& R, int& C) { const int st = b / 1024, sb = b % 1024, swz = sb ^ (((sb >> 9) & 1) << 5); R = (st >> 1) * 16 + swz / 64; C = (st & 1) * 32 + (swz % 64) / 2; }
__host__ __device__ __forceinline__ int perm32(int rho) { const int n = rho >> 4, i = rho & 15; return 8 * (i >> 2) + 4 * n + (i & 3); }

struct Unit { int pm, pn; };
struct Gemm { const bf16_t* A; const bf16_t* Bt; int M, N, K; };

struct StaticOrder {
    int nM, nN, nwg, G, c;
    __host__ __device__ void init(int M, int N, int G_, int c_) { nM = M / BM; nN = N / BM; nwg = nM * nN; G = G_; c = c_; }
    __host__ __device__ bool next(int i, Unit& u) const {
        const long L = (long)i * G + c; if (L >= nwg) return false;
        int wgid = (int)L; { const int q = nwg / NXCD, r = nwg % NXCD, xcd = wgid % NXCD, off = wgid / NXCD; wgid = (xcd < r ? xcd * (q + 1) : r * (q + 1) + (xcd - r) * q) + off; }
        const int nig = WGM * nN, gid = wgid / nig, fm = gid * WGM, gsz = (nM - fm) < WGM ? (nM - fm) : WGM;
        u.pm = fm + ((wgid % nig) % gsz); u.pn = (wgid % nig) / gsz; return true;
    }
    __device__ __forceinline__ void a_ready(const Unit&) const {}
    __device__ __forceinline__ void done(const Unit&) const {}
};

__device__ __forceinline__ unsigned cvt_pk_bf16(float lo, float hi) { unsigned r; asm volatile("v_cvt_pk_bf16_f32 %0, %1, %2" : "=v"(r) : "v"(lo), "v"(hi)); return r; }
template <class Epi, class Sched, bool ALIGN_EPI = false, bool SP2 = false>
__device__ __forceinline__ void gemm_phase(PG8_LAS unsigned char* lds, const Gemm g, const Sched& S, const Epi& E) {
    const int tid = mk_tid(), wid = __builtin_amdgcn_readfirstlane(tid >> 6), lane = tid & 63, wr = wid >> 2, wc = wid & 3, fr = lane & 15, fq = lane >> 4;
    const int K = g.K, nt = K / BK;
    unsigned voffA[2], voffB[2];
#pragma unroll
    for (int i = 0; i < 2; ++i) { int R, C; stage_rc(tid * 16 + i * 8192, R, C); const int Rb = Epi::PERM ? ((R & ~31) + perm32(R & 31)) : R;
        voffA[i] = (unsigned)(R * K + C) * 2u; voffB[i] = (unsigned)(Rb * K + C) * 2u; }
    const size_t kstep = (size_t)(BK * 2);
    const size_t hstep = (size_t)HALF * K * 2;
    const size_t tstep = 2 * hstep;
    const unsigned ldsw = (unsigned)wid * 1024u;
    const int aoff = lds_byte(wr * 64 + fr, fq * 8), boff = lds_byte(wc * 32 + fr, fq * 8);
#define PG8_SA(b, h) (((b) * 2 + (h)) * HTB)
#define PG8_SB(b, h) ((4 + (b) * 2 + (h)) * HTB)
#define PG8_STAGE(bufoff, gbase, voff) do { _Pragma("unroll") for (int _i = 0; _i < 2; ++_i) \
        __builtin_amdgcn_global_load_lds((const unsigned*)((const char*)(gbase) + (voff)[_i]), (PG8_LAS unsigned*)(lds + (bufoff) + ldsw + _i * 8192), 16, 0, 0); } while (0)
#define PG8_LDA(dst, b, h) do { _Pragma("unroll") for (int m = 0; m < 4; ++m) _Pragma("unroll") for (int k = 0; k < 2; ++k) dst[m][k] = *(const PG8_LAS bf16x8*)(lds + PG8_SA(b, h) + aoff + m * 2048 + k * 1024); } while (0)
#define PG8_LDB(dst, b, h) do { _Pragma("unroll") for (int n = 0; n < 2; ++n) _Pragma("unroll") for (int k = 0; k < 2; ++k) dst[n][k] = *(const PG8_LAS bf16x8*)(lds + PG8_SB(b, h) + boff + n * 2048 + k * 1024); } while (0)
#define PG8_MMA(ai, bj, At, Bt) do { __builtin_amdgcn_s_setprio(1); _Pragma("unroll") for (int m = 0; m < 4; ++m) _Pragma("unroll") for (int n = 0; n < 2; ++n) _Pragma("unroll") for (int k = 0; k < 2; ++k) \
        acc[ai][bj][m][n] = __builtin_amdgcn_mfma_f32_16x16x32_bf16(Bt[n][k], At[m][k], acc[ai][bj][m][n], 0, 0, 0); __builtin_amdgcn_s_setprio(0); } while (0)
#define PG8_WAIT_V(n) asm volatile("s_waitcnt vmcnt(" #n ")" ::: "memory")
#define PG8_WAIT_L(n) asm volatile("s_waitcnt lgkmcnt(" #n ")" ::: "memory")
#define PG8_BAR __builtin_amdgcn_s_barrier()
#define PG8_SCHED __builtin_amdgcn_sched_barrier(0)
    Unit cur, nxt; int ui = 0;
    if (!S.next(0, cur)) return;
    f32x4 acc[2][2][4][2];
#pragma unroll
    for (int a = 0; a < 2; ++a)
#pragma unroll
        for (int b = 0; b < 2; ++b)
#pragma unroll
            for (int m = 0; m < 4; ++m)
#pragma unroll
                for (int n = 0; n < 2; ++n) acc[a][b][m][n] = (f32x4){0.f, 0.f, 0.f, 0.f};
    bf16x8 At[4][2], B0[2][2], B1[2][2];
    const char* cA = (const char*)g.A + (size_t)cur.pm * tstep; const char* cB = (const char*)g.Bt + (size_t)cur.pn * tstep;
    S.a_ready(cur);
    if constexpr (SP2) {
        PG8_STAGE(PG8_SB(0, 0), cB, voffB); PG8_STAGE(PG8_SB(0, 1), cB + hstep, voffB); PG8_STAGE(PG8_SA(0, 0), cA, voffA); PG8_STAGE(PG8_SA(0, 1), cA + hstep, voffA);
        if (wr == 1) PG8_BAR;
        PG8_WAIT_V(2); PG8_BAR;
        PG8_STAGE(PG8_SB(1, 0), cB + kstep, voffB); PG8_STAGE(PG8_SA(1, 0), cA + kstep, voffA); PG8_STAGE(PG8_SB(1, 1), cB + hstep + kstep, voffB);
        PG8_WAIT_V(6); PG8_BAR;
    } else {
        PG8_STAGE(PG8_SB(0, 0), cB, voffB); PG8_STAGE(PG8_SA(0, 0), cA, voffA); PG8_STAGE(PG8_SB(0, 1), cB + hstep, voffB); PG8_STAGE(PG8_SA(0, 1), cA + hstep, voffA);
        if (wr == 1) PG8_BAR;
        PG8_WAIT_V(4); PG8_BAR;
        PG8_STAGE(PG8_SB(1, 0), cB + kstep, voffB); PG8_STAGE(PG8_SA(1, 0), cA + kstep, voffA); PG8_STAGE(PG8_SB(1, 1), cB + hstep + kstep, voffB);
        PG8_WAIT_V(6); PG8_BAR;
    }
    for (;;) {
        const bool has_next = S.next(ui + 1, nxt);
        const char* nA = has_next ? (const char*)g.A + (size_t)nxt.pm * tstep : cA; const char* nB = has_next ? (const char*)g.Bt + (size_t)nxt.pn * tstep : cB;
        for (int t = 0; t < nt; t += 2) {
            const bool last = (t == nt - 2);
            const char* a1 = cA + (size_t)(t + 1) * kstep;
            const char* a2 = last ? nA : cA + (size_t)(t + 2) * kstep; const char* b2 = last ? nB : cB + (size_t)(t + 2) * kstep;
            const char* a3 = a2 + kstep; const char* b3 = b2 + kstep;
            if (last && has_next) S.a_ready(nxt);
            if constexpr (SP2) {
            PG8_LDB(B0, 0, 0); PG8_LDB(B1, 0, 1); PG8_SCHED; PG8_LDA(At, 0, 0); PG8_STAGE(PG8_SA(1, 1), a1 + hstep, voffA);
            PG8_WAIT_V(8); PG8_WAIT_L(0); PG8_BAR; PG8_MMA(0, 0, At, B0); PG8_MMA(0, 1, At, B1); PG8_BAR; PG8_SCHED;
            PG8_LDA(At, 0, 1); PG8_STAGE(PG8_SB(0, 0), b2, voffB); PG8_STAGE(PG8_SB(0, 1), b2 + hstep, voffB); PG8_STAGE(PG8_SA(0, 0), a2, voffA);
            PG8_WAIT_V(8); PG8_WAIT_L(0); PG8_BAR; PG8_MMA(1, 0, At, B0); PG8_MMA(1, 1, At, B1); PG8_BAR; PG8_SCHED;
            PG8_LDB(B0, 1, 0); PG8_LDB(B1, 1, 1); PG8_SCHED; PG8_LDA(At, 1, 0); PG8_STAGE(PG8_SA(0, 1), a2 + hstep, voffA);
            PG8_WAIT_V(8); PG8_WAIT_L(0); PG8_BAR; PG8_MMA(0, 0, At, B0); PG8_MMA(0, 1, At, B1); PG8_BAR; PG8_SCHED;
            PG8_LDA(At, 1, 1); PG8_STAGE(PG8_SB(1, 0), b3, voffB); PG8_STAGE(PG8_SB(1, 1), b3 + hstep, voffB); PG8_STAGE(PG8_SA(1, 0), a3, voffA);
            PG8_WAIT_V(8); PG8_WAIT_L(0); PG8_BAR; PG8_MMA(1, 0, At, B0); PG8_MMA(1, 1, At, B1); PG8_BAR; PG8_SCHED;
            } else {
            PG8_LDB(B0, 0, 0); PG8_SCHED; PG8_LDA(At, 0, 0); PG8_STAGE(PG8_SA(1, 1), a1 + hstep, voffA);
            PG8_WAIT_L(8); PG8_BAR; PG8_WAIT_L(0); PG8_MMA(0, 0, At, B0); PG8_BAR; PG8_SCHED;
            PG8_LDB(B1, 0, 1); PG8_STAGE(PG8_SB(0, 0), b2, voffB);
            PG8_BAR; PG8_WAIT_L(0); PG8_MMA(0, 1, At, B1); PG8_BAR;
            PG8_LDA(At, 0, 1); PG8_STAGE(PG8_SA(0, 0), a2, voffA);
            PG8_BAR; PG8_WAIT_L(0); PG8_MMA(1, 0, At, B0); PG8_BAR; PG8_SCHED;
            PG8_STAGE(PG8_SB(0, 1), b2 + hstep, voffB);
            PG8_WAIT_V(6); PG8_BAR; PG8_MMA(1, 1, At, B1); PG8_BAR;
            PG8_LDB(B0, 1, 0); PG8_SCHED; PG8_LDA(At, 1, 0); PG8_STAGE(PG8_SA(0, 1), a2 + hstep, voffA);
            PG8_WAIT_L(8); PG8_BAR; PG8_WAIT_L(0); PG8_MMA(0, 0, At, B0); PG8_BAR; PG8_SCHED;
            PG8_LDB(B1, 1, 1); PG8_STAGE(PG8_SB(1, 0), b3, voffB);
            PG8_BAR; PG8_WAIT_L(0); PG8_MMA(0, 1, At, B1); PG8_BAR;
            PG8_LDA(At, 1, 1); PG8_STAGE(PG8_SA(1, 0), a3, voffA);
            PG8_BAR; PG8_WAIT_L(0); PG8_MMA(1, 0, At, B0); PG8_BAR; PG8_SCHED;
            PG8_STAGE(PG8_SB(1, 1), b3 + hstep, voffB);
            PG8_WAIT_V(6); PG8_BAR; PG8_MMA(1, 1, At, B1); PG8_BAR;
            }
        }
        if constexpr (ALIGN_EPI) { if (wr == 0) PG8_BAR; }
        if constexpr (!Epi::AFTER_DRAIN) { E(acc, cur, wr, wc, fr, fq); S.done(cur); }
        if (!has_next) break;
#pragma unroll
        for (int a = 0; a < 2; ++a)
#pragma unroll
            for (int b = 0; b < 2; ++b)
#pragma unroll
                for (int m = 0; m < 4; ++m)
#pragma unroll
                    for (int n = 0; n < 2; ++n) acc[a][b][m][n] = (f32x4){0.f, 0.f, 0.f, 0.f};
        cur = nxt; cA = nA; cB = nB; ++ui;
        if constexpr (ALIGN_EPI) { if (wr == 1) PG8_BAR; }
    }
    PG8_WAIT_V(0);
    if constexpr (!ALIGN_EPI) { if (wr == 0) PG8_BAR; }
    PG8_BAR;
    if constexpr (Epi::AFTER_DRAIN) { E.fused(acc, cur, wr, wc, fr, fq, lds, wid, lane); S.done(cur); }
#undef PG8_SA
#undef PG8_SB
#undef PG8_STAGE
#undef PG8_LDA
#undef PG8_LDB
#undef PG8_MMA
#undef PG8_WAIT_V
#undef PG8_WAIT_L
#undef PG8_BAR
#undef PG8_SCHED
}
}

#define DI __device__ __forceinline__
#define LAS __attribute__((address_space(3)))
typedef unsigned short bf16_t;
typedef short bf16x8 __attribute__((ext_vector_type(8)));
typedef short s16x4 __attribute__((ext_vector_type(4)));
typedef float f32x4 __attribute__((ext_vector_type(4)));
typedef float f32x16 __attribute__((ext_vector_type(16)));
typedef unsigned u32x4 __attribute__((ext_vector_type(4)));
typedef unsigned u32x2 __attribute__((ext_vector_type(2)));
typedef float f32x2_t __attribute__((ext_vector_type(2)));
typedef __bf16 bf16x2_t __attribute__((ext_vector_type(2)));
typedef short v4i16_t __attribute__((ext_vector_type(4)));

constexpr int NTHREADS = 512, NWAVES = 8;
constexpr int BATCH = 8, SEQ = 2048, DM = 1024, NH = 16, HD = 64, MTOK = BATCH * SEQ;
constexpr int FOX_IN = 4 * DM + NH, DSW_IN = 10 * DM;
constexpr float EPS = 1e-6f;
constexpr float LOG2E = 1.4426950408889634f;
constexpr float C2 = 0.125f * LOG2E;
constexpr int LDS_BYTES = 147456;

constexpr size_t MiB = 1u << 20;
constexpr size_t WS_CTL = 0, CTL_ZERO_BYTES = 16384;
constexpr size_t WS_ROT = 1 * MiB;
constexpr size_t WS_SSQ = 2 * MiB;
constexpr size_t WS_CLOC = 3 * MiB;
constexpr size_t WS_CTOT = 4 * MiB;
constexpr size_t WS_WF = 5 * MiB;
constexpr size_t WS_WFOX = 8 * MiB;
constexpr size_t WS_WDSW = 24 * MiB;
constexpr size_t WS_WOUT = 64 * MiB;
constexpr size_t WS_XB = 72 * MiB;
constexpr size_t WS_AO = 104 * MiB;
constexpr size_t WS_PROJ = 136 * MiB;
constexpr size_t WS_END = 296 * MiB;

DI unsigned cvtpk(float lo, float hi) { f32x2_t v = {lo, hi}; bf16x2_t b = __builtin_convertvector(v, bf16x2_t); return __builtin_bit_cast(unsigned, b); }
DI float bf_lo(unsigned w) { return __uint_as_float(w << 16); }
DI float bf_hi(unsigned w) { return __uint_as_float(w & 0xffff0000u); }
DI float fexp2(float x) { return __builtin_amdgcn_exp2f(x); }
DI float silu(float g) { return g / (1.f + __expf(-g)); }
DI s16x4 vtr(const void* p) { return __builtin_bit_cast(s16x4, __builtin_amdgcn_ds_read_tr16_b64_v4i16((LAS v4i16_t*)p)); }
DI int crow(int i, int hi) { return (i & 3) + 8 * (i >> 2) + 4 * hi; }
#define MFMA32(a, b, c) __builtin_amdgcn_mfma_f32_32x32x16_bf16((a), (b), (c), 0, 0, 0)
DI bf16x8 pack8(float a0, float a1, float a2, float a3, float a4, float a5, float a6, float a7) {
    u32x4 w; w.x = cvtpk(a0, a1); w.y = cvtpk(a2, a3); w.z = cvtpk(a4, a5); w.w = cvtpk(a6, a7); return __builtin_bit_cast(bf16x8, w);
}

DI float xsum16(float s) { auto r = __builtin_amdgcn_permlane16_swap(__float_as_uint(s), __float_as_uint(s), false, false); return __uint_as_float(r[0]) + __uint_as_float(r[1]); }
DI float xsum32(float s) { auto r = __builtin_amdgcn_permlane32_swap(__float_as_uint(s), __float_as_uint(s), false, false); return __uint_as_float(r[0]) + __uint_as_float(r[1]); }
DI float xchg16(float v, bool odd_row) { auto r = __builtin_amdgcn_permlane16_swap(__float_as_uint(v), __float_as_uint(v), false, false); return __uint_as_float(odd_row ? r[0] : r[1]); }
struct EpiProj {
    static constexpr bool PERM = true, AFTER_DRAIN = false;
    bf16_t* out; size_t mats;
    const float* ssq; const float* rot; int row_off;
    const float* qg; const float* kg; int nq;
    DI void operator()(const f32x4 (&acc)[2][2][4][2], const pg8::Unit& u, int wr, int wc, int fr, int fq) const {
        const int mat = u.pn >> 2, head = (u.pn & 3) * 4 + wc;
        const int kind = mat < nq ? 1 : (mat < 2 * nq ? 2 : 0);
        const float* gp = kind == 1 ? qg + 64 * mat : kg + 64 * (mat - nq);
        f32x4 gn[2][2];
#pragma unroll
        for (int bj = 0; bj < 2; ++bj)
#pragma unroll
            for (int n = 0; n < 2; ++n) gn[bj][n] = kind ? *(const f32x4*)(gp + 32 * bj + 8 * fq + 4 * n) : (f32x4){1.f, 1.f, 1.f, 1.f};
        const float qs = kind == 1 ? C2 : 1.f;
        bf16_t* obase = out + (size_t)mat * mats + head * 64 + 8 * fq;
        const bool rotl = (nq == 3) && kind && fq < 2;
        float rstd[8];
#pragma unroll
        for (int hb = 0; hb < 2; ++hb) {
            f32x4 sp[4];
#pragma unroll
            for (int r = 0; r < 4; ++r) { const int row = u.pm * 256 + hb * 128 + wr * 64 + r * 16 + fr; sp[r] = *(const f32x4*)(ssq + (size_t)(row_off + row) * 16 + 4 * fq); }
#pragma unroll
            for (int r = 0; r < 4; ++r) { float t = (sp[r][0] + sp[r][1]) + (sp[r][2] + sp[r][3]); t = xsum16(t); t = xsum32(t); rstd[4 * hb + r] = rsqrtf(t * (1.f / DM) + EPS); }
        }
        f32x4 rc0 = {}, rc1 = {}, rs0 = {}, rs1 = {};
        if (rotl) { const float* rp = rot + (size_t)(row_off + u.pm * 256 + wr * 64 + fr) * 16; rc0 = *(const f32x4*)rp; rc1 = *(const f32x4*)(rp + 4); rs0 = *(const f32x4*)(rp + 8); rs1 = *(const f32x4*)(rp + 12); }
#pragma unroll
        for (int r = 0; r < 8; ++r) {
            const int ai = r >> 2, m = r & 3;
            const int row = u.pm * 256 + ai * 128 + wr * 64 + m * 16 + fr;
            const f32x4 c0 = rc0, c1 = rc1, s0 = rs0, s1 = rs1;
            if (rotl && r < 7) { const int rn = u.pm * 256 + ((r + 1) >> 2) * 128 + wr * 64 + ((r + 1) & 3) * 16 + fr; const float* rp = rot + (size_t)(row_off + rn) * 16;
                rc0 = *(const f32x4*)rp; rc1 = *(const f32x4*)(rp + 4); rs0 = *(const f32x4*)(rp + 8); rs1 = *(const f32x4*)(rp + 12); }
            f32x4 v[2][2];
#pragma unroll
            for (int bj = 0; bj < 2; ++bj)
#pragma unroll
                for (int n = 0; n < 2; ++n) v[bj][n] = acc[ai][bj][m][n] * rstd[r];
            if (kind) {
                float ss = 0.f;
#pragma unroll
                for (int bj = 0; bj < 2; ++bj)
#pragma unroll
                    for (int n = 0; n < 2; ++n) ss += (v[bj][n][0] * v[bj][n][0] + v[bj][n][1] * v[bj][n][1]) + (v[bj][n][2] * v[bj][n][2] + v[bj][n][3] * v[bj][n][3]);
                ss = xsum16(ss); ss = xsum32(ss);
                const float hr = rsqrtf(ss * (1.f / HD) + EPS) * qs;
#pragma unroll
                for (int bj = 0; bj < 2; ++bj)
#pragma unroll
                    for (int n = 0; n < 2; ++n) v[bj][n] = v[bj][n] * gn[bj][n] * hr;
                if (nq == 3) {
                    f32x4 o0, o1;
#pragma unroll
                    for (int e = 0; e < 4; ++e) { o0[e] = xchg16(v[0][0][e], fq & 1); o1[e] = xchg16(v[0][1][e], fq & 1); }
                    if (fq == 0) { v[0][0] = v[0][0] * c0 - o0 * s0; v[0][1] = v[0][1] * c1 - o1 * s1; }
                    else if (fq == 1) { v[0][0] = v[0][0] * c0 + o0 * s0; v[0][1] = v[0][1] * c1 + o1 * s1; }
                }
            }
            int prow = row;
            if (nq == 3 && mat < 9) { const int gi = mat % 3;
                if (gi == 1) prow = (row & ~511) + ((row & 3) << 7) + ((row & 511) >> 2);
                else if (gi == 2) prow = (row & ~511) + ((row & 15) << 5) + ((row & 511) >> 4); }
            bf16_t* rowp = obase + (size_t)prow * DM;
#pragma unroll
            for (int bj = 0; bj < 2; ++bj) {
                u32x4 w; w.x = cvtpk(v[bj][0][0], v[bj][0][1]); w.y = cvtpk(v[bj][0][2], v[bj][0][3]); w.z = cvtpk(v[bj][1][0], v[bj][1][1]); w.w = cvtpk(v[bj][1][2], v[bj][1][3]);
                *(u32x4*)(rowp + 32 * bj) = w;
            }
        }
    }
};

struct EpiOut {
    static constexpr bool PERM = false, AFTER_DRAIN = false;
    const float* xin; float* xout; bf16_t* xb; float* ssq; int last;
    DI void operator()(const f32x4 (&acc)[2][2][4][2], const pg8::Unit& u, int wr, int wc, int fr, int fq) const {
        const int col0 = u.pn * 256 + wc * 32 + 4 * fq;
#pragma unroll
        for (int ai = 0; ai < 2; ++ai)
#pragma unroll
            for (int m = 0; m < 4; ++m) {
                const size_t row = (size_t)(u.pm * 256 + ai * 128 + wr * 64 + m * 16 + fr);
                float ss = 0.f;
#pragma unroll
                for (int bj = 0; bj < 2; ++bj)
#pragma unroll
                    for (int n = 0; n < 2; ++n) {
                        const size_t off = row * DM + col0 + bj * 128 + n * 16;
                        const f32x4 xo = *(const f32x4*)(xin + off) + acc[ai][bj][m][n];
                        *(f32x4*)(xout + off) = xo;
                        if (!last) { u32x2 w; w.x = cvtpk(xo[0], xo[1]); w.y = cvtpk(xo[2], xo[3]); *(u32x2*)(xb + off) = w; }
                        ss += (xo[0] * xo[0] + xo[1] * xo[1]) + (xo[2] * xo[2] + xo[3] * xo[3]);
                    }
                ss = xsum16(ss); ss = xsum32(ss);
                if (fq == 0 && !last) ssq[row * 16 + u.pn * 4 + wc] = ss;
            }
    }
};

DI float wave_sum(float v) {
#pragma unroll
    for (int o = 1; o < 64; o <<= 1) v += __shfl_xor(v, o);
    return v;
}
DI void transpose_item(const float* W, int ldw, int N, bf16_t* WT, const float* gain, bool perm, float* scr, int item, int lane) {
    const int nblk = N / 32, kb = item / nblk, nb = item % nblk, k0 = 64 * kb, n0 = 32 * nb;
    const int c0 = perm ? ((n0 & ~255) + 64 * ((n0 >> 5) & 3) + 32 * ((n0 >> 7) & 1)) : n0;
    {
        f32x4 w[8];
#pragma unroll
        for (int i = 0; i < 8; ++i) w[i] = *(const f32x4*)(W + (size_t)(k0 + 8 * i + (lane >> 3)) * ldw + c0 + 4 * (lane & 7));
#pragma unroll
        for (int i = 0; i < 8; ++i) { const int kk = 8 * i + (lane >> 3); const float g = gain ? gain[k0 + kk] : 1.f; float* d = scr + kk * 33 + 4 * (lane & 7);
            d[0] = w[i][0] * g; d[1] = w[i][1] * g; d[2] = w[i][2] * g; d[3] = w[i][3] * g; }
    }
    const int c = lane & 7;
#pragma unroll
    for (int j = 0; j < 4; ++j) { const int n = (lane >> 3) + 8 * j; const float* s = scr + (8 * c) * 33 + n;
        u32x4 o; o.x = cvtpk(s[0 * 33], s[1 * 33]); o.y = cvtpk(s[2 * 33], s[3 * 33]); o.z = cvtpk(s[4 * 33], s[5 * 33]); o.w = cvtpk(s[6 * 33], s[7 * 33]);
        *(u32x4*)(WT + (size_t)(n0 + n) * DM + k0 + 8 * c) = o; }
}

struct Args {
    const float* x; const int* pos; const float* norm_g; const float* fox_w_in; const float* fox_b_f; const float* fox_qn; const float* fox_kn; const float* fox_w_out;
    const float* dsw_w_in; const float* dsw_qn; const float* dsw_kn; const float* dsw_w_out; float* out; unsigned char* ws;
};

DI void prologue(const Args& a, unsigned char* lds) {
    const int tid = mk_tid(), lane = tid & 63, wave = tid >> 6;
    const int gw = blockIdx.x * NWAVES + wave, NGW = gridDim.x * NWAVES;
    float* scr = (float*)(lds + wave * 8448);
    unsigned char* ws = a.ws;
    constexpr int I_FOX = 16 * (4096 / 32), I_DSW = 16 * (10240 / 32), I_OUT = 16 * (1024 / 32);
    constexpr int NITEMS = 2 * I_FOX + 2 * I_DSW + 4 * I_OUT;
    for (int it = gw; it < NITEMS; it += NGW) {
        int r = it;
        if (r < 2 * I_FOX) { const int j = r / I_FOX; transpose_item(a.fox_w_in + (size_t)j * DM * FOX_IN, FOX_IN, 4096, (bf16_t*)(ws + WS_WFOX) + (size_t)j * 4096 * DM, a.norm_g + 2 * j * DM, true, scr, r % I_FOX, lane); continue; }
        r -= 2 * I_FOX;
        if (r < 2 * I_DSW) { const int j = r / I_DSW; transpose_item(a.dsw_w_in + (size_t)j * DM * DSW_IN, DSW_IN, 10240, (bf16_t*)(ws + WS_WDSW) + (size_t)j * 10240 * DM, a.norm_g + (2 * j + 1) * DM, true, scr, r % I_DSW, lane); continue; }
        r -= 2 * I_DSW;
        { const int L = r / I_OUT, j = L >> 1; const float* W = (L & 1) ? a.dsw_w_out + (size_t)j * DM * DM : a.fox_w_out + (size_t)j * DM * DM;
          transpose_item(W, DM, 1024, (bf16_t*)(ws + WS_WOUT) + (size_t)L * DM * DM, nullptr, false, scr, r % I_OUT, lane); }
    }
    { bf16_t* wf = (bf16_t*)(ws + WS_WF);
      for (int e = blockIdx.x * NTHREADS + tid; e < 2 * 16 * DM; e += gridDim.x * NTHREADS) {
          const int j = e >> 14, h = (e >> 10) & 15, k = e & 1023;
          const float v = a.norm_g[2 * j * DM + k] * a.fox_w_in[(size_t)j * DM * FOX_IN + (size_t)k * FOX_IN + 4096 + h];
          const unsigned hi = cvtpk(v, 0.f) & 0xffffu; const float r = v - __uint_as_float(hi << 16);
          wf[(size_t)(j * 2 + 0) * 16 * DM + h * DM + k] = (bf16_t)hi; wf[(size_t)(j * 2 + 1) * 16 * DM + h * DM + k] = (bf16_t)(cvtpk(r, 0.f) & 0xffffu); } }
    { float* rot = (float*)(ws + WS_ROT);
      const double invf[8] = {1.0, 0.19392274474868576, 0.03760603093086393, 0.007292664737217109, 0.001414213562373095, 0.0002742481756762073, 5.318295896944988e-05, 1.031338537721246e-05};
      for (int e = blockIdx.x * NTHREADS + tid; e < MTOK * 8; e += gridDim.x * NTHREADS) {
          const int t = e >> 3, i = e & 7;
          double f = 1.0;
#pragma unroll
          for (int q = 0; q < 8; ++q) f = (i == q) ? invf[q] : f;
          const double ang = (double)a.pos[t] * f;
          const double k2 = __builtin_rint(ang * 0.15915494309189535);
          const float r = (float)(ang - k2 * 6.283185307179586);
          rot[(size_t)t * 16 + i] = cosf(r); rot[(size_t)t * 16 + 8 + i] = sinf(r); } }
    { bf16_t* xb = (bf16_t*)(ws + WS_XB); float* ssq = (float*)(ws + WS_SSQ);
      for (int m = gw; m < MTOK; m += 2 * NGW) {
          const int m2 = m + NGW; const bool two = m2 < MTOK;
          const f32x4* xr = (const f32x4*)(a.x + (size_t)m * DM) + lane; const f32x4* xr2 = (const f32x4*)(a.x + (size_t)(two ? m2 : m) * DM) + lane;
          f32x4 v[4], w2[4];
#pragma unroll
          for (int j = 0; j < 4; ++j) { v[j] = xr[64 * j]; w2[j] = xr2[64 * j]; }
          float s = 0.f, s2 = 0.f;
#pragma unroll
          for (int j = 0; j < 4; ++j) { s += (v[j][0] * v[j][0] + v[j][1] * v[j][1]) + (v[j][2] * v[j][2] + v[j][3] * v[j][3]); s2 += (w2[j][0] * w2[j][0] + w2[j][1] * w2[j][1]) + (w2[j][2] * w2[j][2] + w2[j][3] * w2[j][3]);
              u32x2 w; w.x = cvtpk(v[j][0], v[j][1]); w.y = cvtpk(v[j][2], v[j][3]); *((u32x2*)(xb + (size_t)m * DM) + lane + 64 * j) = w;
              if (two) { u32x2 q; q.x = cvtpk(w2[j][0], w2[j][1]); q.y = cvtpk(w2[j][2], w2[j][3]); *((u32x2*)(xb + (size_t)m2 * DM) + lane + 64 * j) = q; } }
          s = wave_sum(s); s2 = wave_sum(s2);
          if (lane < 16) { ssq[(size_t)m * 16 + lane] = lane == 0 ? s : 0.f; if (two) ssq[(size_t)m2 * 16 + lane] = lane == 0 ? s2 : 0.f; }
      } }
}

DI void fg_step(const float* x, const bf16_t* wf, const float* b_f, float* cloc, float* ctot, unsigned char* lds) {
    const int tid = mk_tid(), lane = tid & 63, wave = tid >> 6;
    float* ls = (float*)lds;
    float* part = (float*)(lds + 4096);
    for (int chunk = blockIdx.x; chunk < MTOK / 64; chunk += gridDim.x) {
        {
            const int tile = wave & 3, kh = wave >> 2;
            const int row = lane & 15, kg = lane >> 4; const size_t tok = (size_t)chunk * 64 + tile * 16 + row;
            const float* xp = x + tok * DM + 512 * kh + 8 * kg; const bf16_t* wh = wf + (size_t)row * DM + 512 * kh + 8 * kg; const bf16_t* wl = wh + 16 * DM;
            f32x4 acc = {0.f, 0.f, 0.f, 0.f}; float ss = 0.f;
#pragma unroll 8
            for (int s = 0; s < 16; ++s) {
                const f32x4 a0 = *(const f32x4*)(xp + 32 * s), a1 = *(const f32x4*)(xp + 32 * s + 4);
                ss += (a0[0] * a0[0] + a0[1] * a0[1]) + (a0[2] * a0[2] + a0[3] * a0[3]) + (a1[0] * a1[0] + a1[1] * a1[1]) + (a1[2] * a1[2] + a1[3] * a1[3]);
                u32x4 h; h.x = cvtpk(a0[0], a0[1]); h.y = cvtpk(a0[2], a0[3]); h.z = cvtpk(a1[0], a1[1]); h.w = cvtpk(a1[2], a1[3]);
                u32x4 l; l.x = cvtpk(a0[0] - bf_lo(h.x), a0[1] - bf_hi(h.x)); l.y = cvtpk(a0[2] - bf_lo(h.y), a0[3] - bf_hi(h.y));
                l.z = cvtpk(a1[0] - bf_lo(h.z), a1[1] - bf_hi(h.z)); l.w = cvtpk(a1[2] - bf_lo(h.w), a1[3] - bf_hi(h.w));
                const bf16x8 ah = __builtin_bit_cast(bf16x8, h), al = __builtin_bit_cast(bf16x8, l);
                const bf16x8 bh = *(const bf16x8*)(wh + 32 * s), bl = *(const bf16x8*)(wl + 32 * s);
                acc = __builtin_amdgcn_mfma_f32_16x16x32_bf16(ah, bh, acc, 0, 0, 0);
                acc = __builtin_amdgcn_mfma_f32_16x16x32_bf16(ah, bl, acc, 0, 0, 0);
                acc = __builtin_amdgcn_mfma_f32_16x16x32_bf16(al, bh, acc, 0, 0, 0);
            }
            if (kh == 1) { float* pp = part + (tile * 64 + lane) * 5; pp[0] = acc[0]; pp[1] = acc[1]; pp[2] = acc[2]; pp[3] = acc[3]; pp[4] = ss; }
            __syncthreads();
            if (kh == 0) {
                const float* pp = part + (tile * 64 + lane) * 5;
                acc[0] += pp[0]; acc[1] += pp[1]; acc[2] += pp[2]; acc[3] += pp[3]; ss += pp[4];
                ss = xsum16(ss); ss = xsum32(ss);
                const float rstd = rsqrtf(ss * (1.f / DM) + EPS);
                const float bf = b_f[lane & 15];
#pragma unroll
                for (int i = 0; i < 4; ++i) {
                    const int t = 4 * kg + i; const float rs = __shfl(rstd, t);
                    const float f = acc[i] * rs + bf;
                    const float v = fminf(f, 0.f) - log1pf(__expf(-fabsf(f)));
                    ls[(tile * 16 + t) * 16 + (lane & 15)] = v;
                }
            }
        }
        __syncthreads();
#pragma unroll
        for (int hh = 0; hh < 2; ++hh) {
            const int head = 2 * wave + hh; float v = ls[lane * 16 + head];
#pragma unroll
            for (int o = 1; o < 64; o <<= 1) { const float t = __shfl_up(v, o); if (lane >= o) v += t; }
            cloc[((size_t)chunk * 64 + lane) * 16 + head] = v;
            if (lane == 63) ctot[(size_t)chunk * 16 + head] = v;
        }
        __syncthreads();
    }
}

DI float xhalf_max(float m) { auto rr = __builtin_amdgcn_permlane32_swap(__float_as_uint(m), __float_as_uint(m), false, false); return fmaxf(__uint_as_float(rr[0]), __uint_as_float(rr[1])); }
DI float max3f(float a, float b, float c) { return fmaxf(fmaxf(a, b), c); }
DI float max2f(float a, float b) { return fmaxf(a, b); }
DI float sub_f(float a, float b) { return a - b; }
DI float add_f(float a, float b) { return a + b; }
DI float mul_f(float a, float b) { return a * b; }
DI float exp_sum16(f32x16& p, float mx) {
    float s0 = 0.f, s1 = 0.f;
#pragma unroll
    for (int i = 0; i < 16; i += 2) { p[i] = fexp2(sub_f(p[i], mx)); p[i + 1] = fexp2(sub_f(p[i + 1], mx)); s0 = add_f(s0, p[i]); s1 = add_f(s1, p[i + 1]); }
    return s0 + s1;
}
DI void scale16(f32x16& o, float a) {
#pragma unroll
    for (int i = 0; i < 16; ++i) o[i] = mul_f(o[i], a);
}

constexpr int FA_ROWB = 144;
constexpr int FA_K = 0, FA_V = 64 * FA_ROWB, FA_BIAS = 2 * 64 * FA_ROWB, FA_BUF = FA_BIAS + 256;
constexpr int FA_PRE = 2 * FA_BUF;

#define LDS_BAR() do { asm volatile("s_waitcnt lgkmcnt(0)" ::: "memory"); __builtin_amdgcn_s_barrier(); asm volatile("" ::: "memory"); } while (0)
DI void fox_compute(const unsigned char* cur, int t, int NT, int qpos, const bf16x8 (&qr)[4], f32x16& o0, f32x16& o1, float& mrow, float& lsum, int r32, int hi, int trb) {
    f32x16 p0, p1;
    { const float* bias = (const float*)(cur + FA_BIAS) + 4 * hi;
#pragma unroll
      for (int g = 0; g < 4; ++g) { const f32x4 b0 = *(const f32x4*)(bias + 8 * g), b1 = *(const f32x4*)(bias + 32 + 8 * g);
#pragma unroll
          for (int e = 0; e < 4; ++e) { p0[4 * g + e] = b0[e]; p1[4 * g + e] = b1[e]; } } }
    { const unsigned char* kb = cur + FA_K + r32 * FA_ROWB + 16 * hi;
      bf16x8 kf0[4], kf1[4];
#pragma unroll
      for (int s = 0; s < 4; ++s) { kf0[s] = *(const bf16x8*)(kb + 32 * s); kf1[s] = *(const bf16x8*)(kb + 32 * FA_ROWB + 32 * s); }
      __builtin_amdgcn_s_setprio(1);
#pragma unroll
      for (int s = 0; s < 4; ++s) { p0 = MFMA32(kf0[s], qr[s], p0); p1 = MFMA32(kf1[s], qr[s], p1); }
      __builtin_amdgcn_s_setprio(0); }
    if (t >= NT - 4) {
        asm volatile("" ::: "memory");
        const int kb0 = 64 * t;
#pragma unroll
        for (int i = 0; i < 16; ++i) { const int kv = kb0 + crow(i, hi); if (kv > qpos) p0[i] = -INFINITY; if (kv + 32 > qpos) p1[i] = -INFINITY; }
    }
    float ma = mrow, mb = max2f(p0[0], p1[0]);
#pragma unroll
    for (int i = 1; i < 16; i += 2) { ma = max3f(ma, p0[i], p1[i]); if (i + 1 < 16) mb = max3f(mb, p0[i + 1], p1[i + 1]); }
    float mx = max2f(ma, mb);
    mx = xhalf_max(mx);
    const float alpha = fexp2(mrow - mx); mrow = mx;
    const float rs = exp_sum16(p0, mx) + exp_sum16(p1, mx);
    lsum = lsum * alpha + rs;
    if (__builtin_amdgcn_ballot_w64(alpha != 1.f) != 0ull) {
        scale16(o0, alpha); scale16(o1, alpha);
    }
    const bf16x8 pf0 = pack8(p0[0], p0[1], p0[2], p0[3], p0[4], p0[5], p0[6], p0[7]), pf1 = pack8(p0[8], p0[9], p0[10], p0[11], p0[12], p0[13], p0[14], p0[15]);
    const bf16x8 pf2 = pack8(p1[0], p1[1], p1[2], p1[3], p1[4], p1[5], p1[6], p1[7]), pf3 = pack8(p1[8], p1[9], p1[10], p1[11], p1[12], p1[13], p1[14], p1[15]);
    const unsigned char* vb = cur + FA_V + trb;
#pragma unroll
    for (int ks = 0; ks < 4; ++ks) {
        const bf16x8 pf = ks == 0 ? pf0 : (ks == 1 ? pf1 : (ks == 2 ? pf2 : pf3));
        const s16x4 a0l = vtr(vb + ks * 16 * FA_ROWB), a0h = vtr(vb + (ks * 16 + 8) * FA_ROWB);
        const s16x4 a1l = vtr(vb + ks * 16 * FA_ROWB + 64), a1h = vtr(vb + (ks * 16 + 8) * FA_ROWB + 64);
        const bf16x8 va0 = __builtin_shufflevector(a0l, a0h, 0, 1, 2, 3, 4, 5, 6, 7), va1 = __builtin_shufflevector(a1l, a1h, 0, 1, 2, 3, 4, 5, 6, 7);
        o0 = MFMA32(va0, pf, o0); o1 = MFMA32(va1, pf, o1);
    }
}

DI void fox_unit(unsigned char* lds, int b, int h, int qb, const bf16_t* Q, const bf16_t* K, const bf16_t* V, const bf16_t* G, bf16_t* AO, const float* cloc, const float* ctot, const float* qn, const float* kn) {
    const int tid = mk_tid(), lane = tid & 63, wid = __builtin_amdgcn_readfirstlane(tid >> 6), r32 = lane & 31, hi = lane >> 5;
    const size_t rowbase = (size_t)b * SEQ; const int q0 = qb * 256, NT = 4 * (qb + 1);
    float* pre = (float*)(lds + FA_PRE);
    if (wid == 0) {
        float v = lane < 32 ? ctot[((size_t)b * 32 + (lane & 31)) * 16 + h] : 0.f; float inc = v;
#pragma unroll
        for (int o = 1; o < 32; o <<= 1) { const float t = __shfl_up(inc, o); if (lane >= o) inc += t; }
        if (lane < 32) pre[lane] = inc - v;
    }
    float qkB;
    { float gq = fabsf(qn[lane]), gk = fabsf(kn[lane]);
#pragma unroll
      for (int o = 1; o < 64; o <<= 1) { gq = fmaxf(gq, __shfl_xor(gq, o)); gk = fmaxf(gk, __shfl_xor(gk, o)); }
      qkB = 64.f * C2 * gq * gk * 1.02f; }
    float* red = (float*)(lds + FA_PRE + 128);
    const int key = tid >> 3, ch = tid & 7;
    const bf16_t* kp = K + (rowbase + key) * DM + h * HD + ch * 8; const bf16_t* vp = V + (rowbase + key) * DM + h * HD + ch * 8;
    const float* cp = cloc + (rowbase + (tid & 63)) * 16 + h;
    bf16x8 qr[4];
    const int qpos = q0 + 32 * wid + r32;
    { const bf16_t* qp = Q + (rowbase + qpos) * DM + h * HD + 8 * hi;
#pragma unroll
      for (int s = 0; s < 4; ++s) qr[s] = *(const bf16x8*)(qp + 16 * s); }
    u32x2 gw8[2][4];
    { const size_t orow_ = (rowbase + qpos) * DM + h * HD + 4 * hi;
#pragma unroll
      for (int mt = 0; mt < 2; ++mt)
#pragma unroll
          for (int g = 0; g < 4; ++g) gw8[mt][g] = *(const u32x2*)(G + orow_ + 32 * mt + 8 * g); }
    u32x4 kA, vA, kB, vB, kC, vC, kD, vD; float cA, cB, cC, cD;
#define FOX_LOAD(t_, kx, vx, cx) do { const int tc_ = (t_) < NT ? NT - 1 - (t_) : 0; const size_t adv_ = (size_t)tc_ * 64 * DM; kx = *(const u32x4*)(kp + adv_); vx = *(const u32x4*)(vp + adv_); cx = cp[(size_t)tc_ * 64 * 16]; } while (0)
#define FOX_WRITE(t_, kx, vx, cx) do { unsigned char* bw_ = lds + ((t_) & 1) * FA_BUF; *(u32x4*)(bw_ + FA_K + key * FA_ROWB + ch * 16) = kx; *(u32x4*)(bw_ + FA_V + key * FA_ROWB + ch * 16) = vx; \
        if (tid < 64) ((float*)(bw_ + FA_BIAS))[tid] = -(cx + pre[NT - 1 - (t_)]) * LOG2E; } while (0)
    FOX_LOAD(0, kA, vA, cA); FOX_LOAD(1, kB, vB, cB); FOX_LOAD(2, kC, vC, cC); FOX_LOAD(3, kD, vD, cD);
    LDS_BAR();
    FOX_WRITE(0, kA, vA, cA);
    LDS_BAR();
    f32x16 o0 = {}, o1 = {}; float mrow = -1e30f, lsum = 0.f;
    const int trb = ((lane >> 4) & 1) * 32 + (lane & 3) * 8 + (4 * hi + ((lane & 15) >> 2)) * FA_ROWB;
    const int tlast = (q0 + 32 * wid + 31) >> 6;
#define FOX_BODY(t_, kl, vl, cl, kw, vw, cw) do { \
        FOX_LOAD((t_) + 4, kl, vl, cl); \
        const bool wskip_ = (t_) >= 4 && __builtin_amdgcn_readfirstlane((int)(qkB + ((const float*)(lds + ((t_) & 1) * FA_BUF + FA_BIAS))[63] < wprev - 160.f));     \
        if (NT - 1 - (t_) <= tlast && !wskip_) fox_compute(lds + ((t_) & 1) * FA_BUF, NT - 1 - (t_), NT, qpos, qr, o0, o1, mrow, lsum, r32, hi, trb); \
        if ((t_) + 1 < NT) FOX_WRITE((t_) + 1, kw, vw, cw); \
        { float wm_ = mrow; _Pragma("unroll") for (int o_ = 1; o_ < 64; o_ <<= 1) wm_ = fminf(wm_, __shfl_xor(wm_, o_)); if (lane == 0) red[((t_) & 1) * 8 + wid] = wm_; wprev = wm_; } \
        LDS_BAR(); \
        if ((t_) >= 3 && (t_) + 1 < NT) { \
            const f32x4 r0_ = *(const f32x4*)(red + ((t_) & 1) * 8), r1_ = *(const f32x4*)(red + ((t_) & 1) * 8 + 4); \
            const float mn_ = fminf(fminf(fminf(r0_[0], r0_[1]), fminf(r0_[2], r0_[3])), fminf(fminf(r1_[0], r1_[1]), fminf(r1_[2], r1_[3]))); \
            const float bn_ = ((const float*)(lds + (((t_) + 1) & 1) * FA_BUF + FA_BIAS))[63]; \
            if (__builtin_amdgcn_readfirstlane((int)(qkB + bn_ < mn_ - 160.f))) goto fox_done; } } while (0)
    float wprev = -1e30f;
#pragma unroll 1
    for (int t = 0; t < NT; t += 4) {
        FOX_BODY(t, kA, vA, cA, kB, vB, cB);
        FOX_BODY(t + 1, kB, vB, cB, kC, vC, cC);
        FOX_BODY(t + 2, kC, vC, cC, kD, vD, cD);
        FOX_BODY(t + 3, kD, vD, cD, kA, vA, cA);
    }
fox_done:
#undef FOX_BODY
#undef FOX_LOAD
#undef FOX_WRITE
    lsum = xsum32(lsum);
    const float inv = 1.f / lsum;
    const size_t orow = (rowbase + qpos) * DM + h * HD + 4 * hi;
#pragma unroll
    for (int mt = 0; mt < 2; ++mt)
#pragma unroll
        for (int g = 0; g < 4; ++g) {
            const size_t off = orow + 32 * mt + 8 * g;
            const u32x2 gw = gw8[mt][g];
            const f32x16& o = mt ? o1 : o0;
            u32x2 w; w.x = cvtpk(o[4 * g] * inv * silu(bf_lo(gw.x)), o[4 * g + 1] * inv * silu(bf_hi(gw.x)));
            w.y = cvtpk(o[4 * g + 2] * inv * silu(bf_lo(gw.y)), o[4 * g + 3] * inv * silu(bf_hi(gw.y)));
            *(u32x2*)(AO + off) = w;
        }
}
DI void fox_attn_phase(unsigned char* lds, const bf16_t* proj, bf16_t* AO, const float* cloc, const float* ctot, const float* qn, const float* kn, unsigned* ctr) {
    const size_t mats = (size_t)MTOK * DM;
    volatile LAS int* slot = (volatile LAS int*)((LAS unsigned char*)lds + FA_PRE + 256);
    for (;;) {
        __syncthreads();
        if (threadIdx.x == 0) { const unsigned v = __hip_atomic_fetch_add(ctr, 1u, __ATOMIC_RELAXED, __HIP_MEMORY_SCOPE_AGENT); *slot = (int)v; }
        __syncthreads();
        const int it = __builtin_amdgcn_readfirstlane(*slot);
        if (it >= 1024) break;
        const int qb = 7 - (it >> 7), bh = it & 127, b = bh >> 4, h = bh & 15;
        fox_unit(lds, b, h, qb, proj, proj + mats, proj + 2 * mats, proj + 3 * mats, AO, cloc, ctot, qn, kn);
    }
}

constexpr int DA_OG = 0, DA_LSE2 = 2 * 256 * 128, DA_LSE = 3 * 256 * 128, DA_VST = DA_LSE + 3 * 256 * 4, DA_VROW = 144, DA_VBYTES = 32 * DA_VROW;
static_assert(DA_VST + 8 * DA_VBYTES <= 140000, "dswa LDS map");

DI void dsw_group(const bf16_t* Qh, const bf16_t* Kh, const bf16_t* Vh, int R, int cls, int e0w, int tq, int jmin, unsigned char* st, const unsigned char* kfb, int trb,
                  int lrow, int lch, int r32, int hi, f32x16& o0, f32x16& o1, float& mrow, float& lsum) {
    bf16x8 qr[4];
    const int sh = R == 1 ? 9 : (R == 4 ? 7 : 5);
#define DSW_ROW(el_) ((((el_) >> sh) << 9) + (cls << sh) + ((el_) & ((1 << sh) - 1)))
    { const bf16_t* qp = Qh + (size_t)DSW_ROW(e0w + r32) * DM + 8 * hi;
#pragma unroll
      for (int s = 0; s < 4; ++s) qr[s] = *(const bf16x8*)(qp + 16 * s); }
    o0 = f32x16{}; o1 = f32x16{}; mrow = -1e30f; lsum = 0.f;
    u32x4 kn[4], vn[4];
#define DSW_LOAD(jj_, kd, vd) do { _Pragma("unroll") for (int it_ = 0; it_ < 4; ++it_) { const size_t o_ = (size_t)DSW_ROW(e0w - 128 + 32 * (jj_) + 8 * it_ + lrow) * DM + 8 * lch; \
        kd[it_] = *(const u32x4*)(Kh + o_); vd[it_] = *(const u32x4*)(Vh + o_); } } while (0)
#define DSW_STAGE(src) do { _Pragma("unroll") for (int it_ = 0; it_ < 4; ++it_) *(u32x4*)(st + (8 * it_ + lrow) * DA_VROW + 16 * lch) = src[it_]; } while (0)
    DSW_LOAD(jmin, kn, vn);
    const int ql = r32 - 4 * hi;
#pragma unroll 1
    for (int jj = jmin; jj < 5; ++jj) {
        u32x4 kc[4], vc[4];
#pragma unroll
        for (int s = 0; s < 4; ++s) { kc[s] = kn[s]; vc[s] = vn[s]; }
        if (jj + 1 < 5) DSW_LOAD(jj + 1, kn, vn);
        DSW_STAGE(kc);
        f32x16 p = {};
        { bf16x8 kf_[4];
#pragma unroll
          for (int s = 0; s < 4; ++s) kf_[s] = *(const bf16x8*)(kfb + 32 * s);
          __builtin_amdgcn_s_setprio(1);
#pragma unroll
          for (int s = 0; s < 4; ++s) p = MFMA32(kf_[s], qr[s], p);
          __builtin_amdgcn_s_setprio(0); }
        DSW_STAGE(vc);
        if (jj == 0) {
            asm volatile("" ::: "memory");
#pragma unroll
            for (int i = 0; i < 16; ++i) p[i] = ((i & 3) + 8 * (i >> 2)) >= ql ? p[i] : -INFINITY;
        } else if (jj == 4) {
            asm volatile("" ::: "memory");
#pragma unroll
            for (int i = 0; i < 16; ++i) p[i] = ((i & 3) + 8 * (i >> 2)) <= ql ? p[i] : -INFINITY;
        }
        float ma = mrow, mb = max2f(p[0], p[1]);
#pragma unroll
        for (int i = 2; i < 16; i += 4) { ma = max3f(ma, p[i], p[i + 1]); if (i + 2 < 16) mb = max3f(mb, p[i + 2], p[i + 3]); }
        float mx = max2f(ma, mb);
        mx = xhalf_max(mx);
        const float alpha = fexp2(mrow - mx); mrow = mx;
        const float rs = exp_sum16(p, mx);
        lsum = lsum * alpha + rs;
        const bf16x8 pf0 = pack8(p[0], p[1], p[2], p[3], p[4], p[5], p[6], p[7]), pf1 = pack8(p[8], p[9], p[10], p[11], p[12], p[13], p[14], p[15]);
        if (__builtin_amdgcn_ballot_w64(alpha != 1.f) != 0ull) { scale16(o0, alpha); scale16(o1, alpha); }
        const unsigned char* vb = st + trb;
#pragma unroll
        for (int ks = 0; ks < 2; ++ks) {
            const bf16x8 pf = ks == 0 ? pf0 : pf1;
            const s16x4 a0l = vtr(vb + ks * 16 * DA_VROW), a0h = vtr(vb + (ks * 16 + 8) * DA_VROW);
            const s16x4 a1l = vtr(vb + ks * 16 * DA_VROW + 64), a1h = vtr(vb + (ks * 16 + 8) * DA_VROW + 64);
            const bf16x8 va0 = __builtin_shufflevector(a0l, a0h, 0, 1, 2, 3, 4, 5, 6, 7), va1 = __builtin_shufflevector(a1l, a1h, 0, 1, 2, 3, 4, 5, 6, 7);
            o0 = MFMA32(va0, pf, o0); o1 = MFMA32(va1, pf, o1);
        }
    }
#undef DSW_LOAD
#undef DSW_STAGE
#undef DSW_ROW
    lsum = xsum32(lsum);
}

DI void dsw_unit(unsigned char* lds, int bl, int sb, int h, const bf16_t* proj, size_t mats, bf16_t* AO) {
    const int tid = mk_tid(), lane = tid & 63, wid = __builtin_amdgcn_readfirstlane(tid >> 6), r32 = lane & 31, hi = lane >> 5;
    const size_t rowbase = (size_t)bl * SEQ; const int T0s = sb * 512;
    unsigned char* st = lds + DA_VST + wid * DA_VBYTES;
    const int lrow = lane >> 3, lch = lane & 7;
    const int trb = ((lane >> 4) & 1) * 32 + (lane & 3) * 8 + (4 * hi + ((lane & 15) >> 2)) * DA_VROW;
    const unsigned char* kfb = st + r32 * DA_VROW + 16 * hi;
    f32x16 o0, o1; float mrow, lsum;
#pragma unroll 1
    for (int qt = 0; qt < 2; ++qt) {
        const int cls = 2 * wid + qt, e0w = T0s >> 4, tq = T0s + 16 * r32 + cls;
        int jmin = 4 - (e0w >> 5); jmin = jmin < 0 ? 0 : jmin;
        const size_t hb = rowbase * DM + h * HD;
        dsw_group(proj + 2 * mats + hb, proj + 5 * mats + hb, proj + 8 * mats + hb, 16, cls, e0w, tq, jmin, st, kfb, trb, lrow, lch, r32, hi, o0, o1, mrow, lsum);
        const float inv = 1.f / lsum;
        bf16_t* orow = AO + (rowbase + tq) * DM + h * HD + 4 * hi;
#pragma unroll
        for (int mt = 0; mt < 2; ++mt)
#pragma unroll
            for (int q = 0; q < 4; ++q) { const f32x16& o = mt ? o1 : o0;
                u32x2 w; w.x = cvtpk(o[4 * q] * inv, o[4 * q + 1] * inv); w.y = cvtpk(o[4 * q + 2] * inv, o[4 * q + 3] * inv);
                *(u32x2*)(orow + 32 * mt + 8 * q) = w; }
        if (hi == 0) ((float*)(lds + DA_LSE2))[tq - T0s] = mrow + __log2f(lsum);
    }
    __syncthreads();
#pragma unroll 1
    for (int half = 0; half < 2; ++half) {
        const int T0 = T0s + 256 * half;
        const size_t coff = (rowbase + T0 + (tid >> 1)) * DM + h * HD + 32 * (tid & 1);
        u32x4 gt4[4];
#pragma unroll
        for (int c = 0; c < 4; ++c) gt4[c] = *(const u32x4*)(proj + 9 * mats + coff + 8 * c);
#pragma unroll 1
        for (int g = 0; g < 2; ++g) {
            const size_t hb = rowbase * DM + h * HD;
            int e0w, cls, tq, R;
            if (g == 0) { R = 1; cls = 0;       e0w = T0 + 32 * wid;                 tq = e0w + r32; }
            else        { R = 4; cls = wid & 3; e0w = (T0 >> 2) + 32 * (wid >> 2);   tq = 4 * (e0w + r32) + cls; }
            int jmin = 4 - (e0w >> 5); jmin = jmin < 0 ? 0 : jmin;
            dsw_group(proj + (size_t)g * mats + hb, proj + (size_t)(3 + g) * mats + hb, proj + (size_t)(6 + g) * mats + hb, R, cls, e0w, tq, jmin, st, kfb, trb, lrow, lch, r32, hi, o0, o1, mrow, lsum);
            const float inv = 1.f / lsum;
            const int tl = tq - T0;
            unsigned char* og = lds + DA_OG + g * 32768 + tl * 128 + 8 * hi;
#pragma unroll
            for (int mt = 0; mt < 2; ++mt)
#pragma unroll
                for (int q = 0; q < 4; ++q) { const f32x16& o = mt ? o1 : o0;
                    u32x2 w; w.x = cvtpk(o[4 * q] * inv, o[4 * q + 1] * inv); w.y = cvtpk(o[4 * q + 2] * inv, o[4 * q + 3] * inv);
                    *(u32x2*)(og + 64 * mt + 16 * q) = w; }
            if (hi == 0) ((float*)(lds + DA_LSE))[g * 256 + tl] = mrow + __log2f(lsum);
        }
        __syncthreads();
        {
            const int tl = tid >> 1, dh = tid & 1;
            const float* lse = (const float*)(lds + DA_LSE);
            const float l0 = lse[tl], l1 = lse[256 + tl], l2 = ((const float*)(lds + DA_LSE2))[256 * half + tl], mx = fmaxf(l0, fmaxf(l1, l2));
            float w0 = fexp2(l0 - mx), w1 = fexp2(l1 - mx), w2 = fexp2(l2 - mx); const float inv = 1.f / (w0 + w1 + w2); w0 *= inv; w1 *= inv; w2 *= inv;
#pragma unroll
            for (int c = 0; c < 4; ++c) {
                const u32x4 a = *(const u32x4*)(lds + DA_OG + tl * 128 + 64 * dh + 16 * c), bq = *(const u32x4*)(lds + DA_OG + 32768 + tl * 128 + 64 * dh + 16 * c),
                            cq = *(const u32x4*)(AO + coff + 8 * c), gt = gt4[c];
                u32x4 w;
#pragma unroll
                for (int e = 0; e < 4; ++e) {
                    const float lo = (w0 * bf_lo(a[e]) + w1 * bf_lo(bq[e]) + w2 * bf_lo(cq[e])) * silu(bf_lo(gt[e]));
                    const float hv = (w0 * bf_hi(a[e]) + w1 * bf_hi(bq[e]) + w2 * bf_hi(cq[e])) * silu(bf_hi(gt[e]));
                    w[e] = cvtpk(lo, hv);
                }
                *(u32x4*)(AO + coff + 8 * c) = w;
            }
        }
        __syncthreads();
    }
}
DI void dsw_attn_phase(unsigned char* lds, const bf16_t* proj, bf16_t* AO_half) {
    const size_t mats = (size_t)(MTOK / 2) * DM;
    for (int u = blockIdx.x; u < 256; u += gridDim.x) dsw_unit(lds, u >> 6, (u >> 4) & 3, u & 15, proj, mats, AO_half);
}

typedef __attribute__((address_space(1))) unsigned gu32;
#define XB_TMO      128
#define XB_XCNT(j)  (256  + 64 * (j))
#define XB_XSUB(j)  (1280 + 64 * (j))
#define XB_XGEN(j)  (2304 + 64 * (j))
#define XB_TOP      3328
#define XB_TOPGEN   3392
#define XCD_BAR_WORDS 3456
#define XB_SPIN_CAP (1u << 18)

__device__ __forceinline__ unsigned xb_ld(unsigned* p)              { return __hip_atomic_load(p, __ATOMIC_RELAXED, __HIP_MEMORY_SCOPE_AGENT); }
__device__ __forceinline__ unsigned xb_add(unsigned* p, unsigned v) { return __hip_atomic_fetch_add(p, v, __ATOMIC_RELAXED, __HIP_MEMORY_SCOPE_AGENT); }
__device__ __forceinline__ unsigned xb_xcc_id() { return (unsigned)__builtin_amdgcn_s_getreg((3 << 11) | 20) & 0xFu; }
#define XB_SPIN(cond, bar) do { unsigned _sp = 0; while (cond) { __builtin_amdgcn_s_sleep(1); \
    if ((++_sp & 255u) == 0u) { if (xb_ld(&(bar)[XB_TMO])) break; if (_sp > XB_SPIN_CAP) { atomicAdd(&(bar)[XB_TMO], 1u); break; } } } } while (0)

struct XcdBarrier {
    unsigned* bar; unsigned x;
    volatile LAS unsigned* st;
};

__device__ __forceinline__ XcdBarrier xcd_barrier_post(unsigned* bar, volatile LAS unsigned* st) {
    XcdBarrier b; b.bar = bar; b.x = xb_xcc_id(); b.st = st;
    if (threadIdx.x == 0) (void)xb_add(&bar[XB_XCNT(b.x)], 1u);
    return b;
}
__device__ __forceinline__ void xcd_barrier_complete(unsigned* bar, unsigned x, unsigned& nloc, unsigned& nx) {
    const unsigned G = gridDim.x * gridDim.y * gridDim.z;
    unsigned sum, cnt, mine, sp = 0u;
    for (;;) {
        sum = 0u; cnt = 0u; mine = 0u;
#pragma unroll
        for (unsigned j = 0; j < 16; ++j) { const unsigned c = xb_ld(&bar[XB_XCNT(j)]); sum += c; cnt += (c > 0u) ? 1u : 0u; mine = (j == x) ? c : mine; }
        if (sum == G) break;
        __builtin_amdgcn_s_sleep(1);
        if ((++sp & 255u) == 0u) { if (xb_ld(&bar[XB_TMO])) break; if (sp > XB_SPIN_CAP) { atomicAdd(&bar[XB_TMO], 1u); break; } }
    }
    nloc = mine > 0u ? mine : 1u; nx = cnt > 0u ? cnt : 1u;
}

__device__ __forceinline__ void xcd_barrier(const XcdBarrier& b) {
    asm volatile("s_waitcnt vmcnt(0)" ::: "memory");
    __syncthreads();
    if (threadIdx.x == 0) {
        unsigned* bar = b.bar;
        __builtin_amdgcn_s_waitcnt(0);
        unsigned nloc = b.st[0], nx = b.st[1];
        if (nloc == 0u) { xcd_barrier_complete(bar, b.x, nloc, nx); b.st[0] = nloc; b.st[1] = nx; }
        const unsigned old = xb_add(&bar[XB_XSUB(b.x)], 1u);
        const unsigned gen = old / nloc;
        if (old + 1u == (gen + 1u) * nloc) {
            __builtin_amdgcn_fence(__ATOMIC_RELEASE, "agent");
            asm volatile("s_waitcnt vmcnt(0)" ::: "memory");
            const unsigned og = xb_add(&bar[XB_TOP], 1u);
            const unsigned tg = og / nx;
            if (og + 1u == (tg + 1u) * nx) xb_add(&bar[XB_TOPGEN], 1u);
            else XB_SPIN(xb_ld(&bar[XB_TOPGEN]) == tg, bar);
            __builtin_amdgcn_fence(__ATOMIC_ACQUIRE, "agent");
            xb_add(&bar[XB_XGEN(b.x)], 1u);
            asm volatile("s_waitcnt vmcnt(0)" ::: "memory");
        } else {
            XB_SPIN(xb_ld(&bar[XB_XGEN(b.x)]) == gen, bar);
            __builtin_amdgcn_fence(__ATOMIC_ACQUIRE, "agent");
            asm volatile("s_waitcnt vmcnt(0)" ::: "memory");
        }
    }
    __syncthreads();
}

__global__ void __launch_bounds__(NTHREADS, 2) fwd_megakernel(Args a) {
    extern __shared__ __attribute__((aligned(16))) unsigned char lds[];
    cg::grid_group grid = cg::this_grid();
    unsigned char* ws = a.ws;
    bf16_t* XB = (bf16_t*)(ws + WS_XB); bf16_t* AO = (bf16_t*)(ws + WS_AO); bf16_t* PROJ = (bf16_t*)(ws + WS_PROJ);
    float* SSQ = (float*)(ws + WS_SSQ); float* ROT = (float*)(ws + WS_ROT); float* CLOC = (float*)(ws + WS_CLOC); float* CTOT = (float*)(ws + WS_CTOT);
    PG8_LAS unsigned char* ldsl = (PG8_LAS unsigned char*)lds;

    volatile LAS unsigned* MISC = (volatile LAS unsigned*)((LAS unsigned char*)lds + LDS_BYTES - 64);
    if (threadIdx.x < 16) MISC[threadIdx.x] = 0u;
    __syncthreads();
    for (int rep = 0; rep < REP_PRO; ++rep) prologue(a, lds);
    if (blockIdx.x == 0) for (int w = threadIdx.x; w < (int)(CTL_ZERO_BYTES / 4); w += NTHREADS) __hip_atomic_store((unsigned*)(ws + WS_CTL) + w, 0u, __ATOMIC_RELAXED, __HIP_MEMORY_SCOPE_AGENT);
    grid.sync();
    XcdBarrier bar = xcd_barrier_post((unsigned*)(ws + WS_CTL), MISC);
#pragma unroll 1
    for (int layer = 0; layer < 4; ++layer) {
        const int j = layer >> 1; const bool dsw = layer & 1;
        const float* xcur = layer == 0 ? a.x : a.out;
        const int nhalf = dsw ? 2 : 1;
#pragma unroll 1
        for (int half = 0; half < nhalf; ++half) {
            if (!dsw) for (int rep = 0; rep < REP_FG; ++rep) fg_step(xcur, (const bf16_t*)(ws + WS_WF) + (size_t)j * 2 * 16 * DM, a.fox_b_f + j * NH, CLOC, CTOT, lds);
            for (int rep = 0; rep < REP_PROJ; ++rep) {
                const int Mg = dsw ? MTOK / 2 : MTOK, Ng = dsw ? 10240 : 4096, row_off = half * (MTOK / 2);
                const bf16_t* Bt = dsw ? (const bf16_t*)(ws + WS_WDSW) + (size_t)j * 10240 * DM : (const bf16_t*)(ws + WS_WFOX) + (size_t)j * 4096 * DM;
                pg8::Gemm g{XB + (size_t)row_off * DM, Bt, Mg, Ng, DM}; pg8::StaticOrder S; S.init(Mg, Ng, (int)gridDim.x, (int)blockIdx.x);
                EpiProj E{PROJ, (size_t)Mg * DM, SSQ, ROT, row_off, dsw ? a.dsw_qn + j * 3 * HD : a.fox_qn + j * HD, dsw ? a.dsw_kn + j * 3 * HD : a.fox_kn + j * HD, dsw ? 3 : 1};
                pg8::gemm_phase<EpiProj, pg8::StaticOrder, true, true>(ldsl, g, S, E);
            }
            xcd_barrier(bar);
            if (!dsw) for (int rep = 0; rep < REP_FOX; ++rep) fox_attn_phase(lds, PROJ, AO, CLOC, CTOT, a.fox_qn + j * HD, a.fox_kn + j * HD, (unsigned*)(ws + WS_CTL) + 3600 + j);
            if (dsw) for (int rep = 0; rep < REP_DSW; ++rep) dsw_attn_phase(lds, PROJ, AO + (size_t)half * (MTOK / 2) * DM);
            xcd_barrier(bar);
        }
        {
            pg8::Gemm g{AO, (const bf16_t*)(ws + WS_WOUT) + (size_t)layer * DM * DM, MTOK, DM, DM}; pg8::StaticOrder S; S.init(MTOK, DM, (int)gridDim.x, (int)blockIdx.x);
            EpiOut E{xcur, a.out, XB, SSQ, layer == 3 ? 1 : 0};
            pg8::gemm_phase<EpiOut, pg8::StaticOrder, true, true>(ldsl, g, S, E);
        }
        if (layer < 3) for (int rep = 0; rep < REP_SYNC; ++rep) xcd_barrier(bar);
    }
}

extern "C" void kernel_launch(void* const* d_in, const int* in_sizes, int n_in, void* d_out, int out_size, void* d_ws, size_t ws_size, hipStream_t stream) {
    static int grid_blocks = 0;
    if (grid_blocks == 0) {
        if (n_in != 12 || in_sizes[0] != MTOK * DM || out_size != MTOK * DM || ws_size < WS_END) {
            fprintf(stderr, "kernel_launch: unexpected shapes (n_in %d, in0 %d, out %d, ws %zu < %zu); nothing launched\n", n_in, n_in > 0 ? in_sizes[0] : -1, out_size, ws_size, (size_t)WS_END); grid_blocks = -1; return; }
        int dev = 0, cus = 0, per_cu = 0;
        hipGetDevice(&dev); hipDeviceGetAttribute(&cus, hipDeviceAttributeMultiprocessorCount, dev);
        if (hipFuncSetAttribute((const void*)fwd_megakernel, hipFuncAttributeMaxDynamicSharedMemorySize, LDS_BYTES) != hipSuccess) { fprintf(stderr, "kernel_launch: hipFuncSetAttribute failed\n"); grid_blocks = -1; return; }
        if (hipOccupancyMaxActiveBlocksPerMultiprocessor(&per_cu, (const void*)fwd_megakernel, NTHREADS, LDS_BYTES) != hipSuccess || per_cu < 1) { fprintf(stderr, "kernel_launch: occupancy query failed (%d)\n", per_cu); grid_blocks = -1; return; }
        grid_blocks = cus * per_cu;
    }
    if (grid_blocks < 0) return;
    Args a{};
    a.x = (const float*)d_in[0]; a.pos = (const int*)d_in[1]; a.norm_g = (const float*)d_in[2]; a.fox_w_in = (const float*)d_in[3]; a.fox_b_f = (const float*)d_in[4];
    a.fox_qn = (const float*)d_in[5]; a.fox_kn = (const float*)d_in[6]; a.fox_w_out = (const float*)d_in[7]; a.dsw_w_in = (const float*)d_in[8]; a.dsw_qn = (const float*)d_in[9];
    a.dsw_kn = (const float*)d_in[10]; a.dsw_w_out = (const float*)d_in[11]; a.out = (float*)d_out; a.ws = (unsigned char*)d_ws;
    void* args[] = {&a};
    hipError_t e = hipLaunchCooperativeKernel((const void*)fwd_megakernel, dim3(grid_blocks), dim3(NTHREADS), args, LDS_BYTES, stream);
    if (e != hipSuccess) fprintf(stderr, "kernel_launch: cooperative launch failed: %s (grid %d)\n", hipGetErrorString(e), grid_blocks);
}
```

```cpp
#include <hip/hip_runtime.h>
#include <hip/hip_cooperative_groups.h>
#include <cstdio>
#include <cstdint>
namespace cg = cooperative_groups;
#define REP_PRO 1
#define REP_FG 1
#define REP_PROJ 1
#define REP_FOX 1
#define REP_DSW 1
#define REP_SYNC 1
__device__ __forceinline__ int mk_tid() { int t = threadIdx.x; asm volatile("" : "+v"(t)); return t; }
namespace pg8 {
#define PG8_LAS __attribute__((address_space(3)))
typedef unsigned short bf16_t;
typedef short bf16x8 __attribute__((ext_vector_type(8)));
typedef float f32x4 __attribute__((ext_vector_type(4)));
typedef unsigned u32x4 __attribute__((ext_vector_type(4)));
constexpr int BM = 256, BK = 64, HALF = 128, HTB = HALF * BK * 2  , STAGE_BYTES = 8 * HTB, NXCD = 8, WGM = 8;

__host__ __device__ __forceinline__ int lds_byte(int r, int c) { const int st = (r >> 4) * 2 + (c >> 5), rr = r & 15, cc = c & 31, ob = rr * 64 + cc * 2; return st * 1024 + (ob ^ (((ob >> 9) & 1) << 5)); }
__host__ __device__ __forceinline__ void stage_rc(int b, int& R, int& C) { const int st = b / 1024, sb = b % 1024, swz = sb ^ (((sb >> 9) & 1) << 5); R = (st >> 1) * 16 + swz / 64; C = (st & 1) * 32 + (swz % 64) / 2; }
__host__ __device__ __forceinline__ int perm32(int rho) { const int n = rho >> 4, i = rho & 15; return 8 * (i >> 2) + 4 * n + (i & 3); }

struct Unit { int pm, pn; };
struct Gemm { const bf16_t* A; const bf16_t* Bt; int M, N, K; };

struct StaticOrder {
    int nM, nN, nwg, G, c;
    __host__ __device__ void init(int M, int N, int G_, int c_) { nM = M / BM; nN = N / BM; nwg = nM * nN; G = G_; c = c_; }
    __host__ __device__ bool next(int i, Unit& u) const {
        const long L = (long)i * G + c; if (L >= nwg) return false;
        int wgid = (int)L; { const int q = nwg / NXCD, r = nwg % NXCD, xcd = wgid % NXCD, off = wgid / NXCD; wgid = (xcd < r ? xcd * (q + 1) : r * (q + 1) + (xcd - r) * q) + off; }
        const int nig = WGM * nN, gid = wgid / nig, fm = gid * WGM, gsz = (nM - fm) < WGM ? (nM - fm) : WGM;
        u.pm = fm + ((wgid % nig) % gsz); u.pn = (wgid % nig) / gsz; return true;
    }
    __device__ __forceinline__ void a_ready(const Unit&) const {}
    __device__ __forceinline__ void done(const Unit&) const {}
};

__device__ __forceinline__ unsigned cvt_pk_bf16(float lo, float hi) { unsigned r; asm volatile("v_cvt_pk_bf16_f32 %0, %1, %2" : "=v"(r) : "v"(lo), "v"(hi)); return r; }
template <class Epi, class Sched, bool ALIGN_EPI = false, bool SP2 = false>
__device__ __forceinline__ void gemm_phase(PG8_LAS unsigned char* lds, const Gemm g, const Sched& S, const Epi& E) {
    const int tid = mk_tid(), wid = __builtin_amdgcn_readfirstlane(tid >> 6), lane = tid & 63, wr = wid >> 2, wc = wid & 3, fr = lane & 15, fq = lane >> 4;
    const int K = g.K, nt = K / BK;
    unsigned voffA[2], voffB[2];
#pragma unroll
    for (int i = 0; i < 2; ++i) { int R, C; stage_rc(tid * 16 + i * 8192, R, C); const int Rb = Epi::PERM ? ((R & ~31) + perm32(R & 31)) : R;
        voffA[i] = (unsigned)(R * K + C) * 2u; voffB[i] = (unsigned)(Rb * K + C) * 2u; }
    const size_t kstep = (size_t)(BK * 2);
    const size_t hstep = (size_t)HALF * K * 2;
    const size_t tstep = 2 * hstep;
    const unsigned ldsw = (unsigned)wid * 1024u;
    const int aoff = lds_byte(wr * 64 + fr, fq * 8), boff = lds_byte(wc * 32 + fr, fq * 8);
#define PG8_SA(b, h) (((b) * 2 + (h)) * HTB)
#define PG8_SB(b, h) ((4 + (b) * 2 + (h)) * HTB)
#define PG8_STAGE(bufoff, gbase, voff) do { _Pragma("unroll") for (int _i = 0; _i < 2; ++_i) \
        __builtin_amdgcn_global_load_lds((const unsigned*)((const char*)(gbase) + (voff)[_i]), (PG8_LAS unsigned*)(lds + (bufoff) + ldsw + _i * 8192), 16, 0, 0); } while (0)
#define PG8_LDA(dst, b, h) do { _Pragma("unroll") for (int m = 0; m < 4; ++m) _Pragma("unroll") for (int k = 0; k < 2; ++k) dst[m][k] = *(const PG8_LAS bf16x8*)(lds + PG8_SA(b, h) + aoff + m * 2048 + k * 1024); } while (0)
#define PG8_LDB(dst, b, h) do { _Pragma("unroll") for (int n = 0; n < 2; ++n) _Pragma("unroll") for (int k = 0; k < 2; ++k) dst[n][k] = *(const PG8_LAS bf16x8*)(lds + PG8_SB(b, h) + boff + n * 2048 + k * 1024); } while (0)
#define PG8_MMA(ai, bj, At, Bt) do { __builtin_amdgcn_s_setprio(1); _Pragma("unroll") for (int m = 0; m < 4; ++m) _Pragma("unroll") for (int n = 0; n < 2; ++n) _Pragma("unroll") for (int k = 0; k < 2; ++k) \
        acc[ai][bj][m][n] = __builtin_amdgcn_mfma_f32_16x16x32_bf16(Bt[n][k], At[m][k], acc[ai][bj][m][n], 0, 0, 0); __builtin_amdgcn_s_setprio(0); } while (0)
#define PG8_WAIT_V(n) asm volatile("s_waitcnt vmcnt(" #n ")" ::: "memory")
#define PG8_WAIT_L(n) asm volatile("s_waitcnt lgkmcnt(" #n ")" ::: "memory")
#define PG8_BAR __builtin_amdgcn_s_barrier()
#define PG8_SCHED __builtin_amdgcn_sched_barrier(0)
    Unit cur, nxt; int ui = 0;
    if (!S.next(0, cur)) return;
    f32x4 acc[2][2][4][2];
#pragma unroll
    for (int a = 0; a < 2; ++a)
#pragma unroll
        for (int b = 0; b < 2; ++b)
#pragma unroll
            for (int m = 0; m < 4; ++m)
#pragma unroll
                for (int n = 0; n < 2; ++n) acc[a][b][m][n] = (f32x4){0.f, 0.f, 0.f, 0.f};
    bf16x8 At[4][2], B0[2][2], B1[2][2];
    const char* cA = (const char*)g.A + (size_t)cur.pm * tstep; const char* cB = (const char*)g.Bt + (size_t)cur.pn * tstep;
    S.a_ready(cur);
    if constexpr (SP2) {
        PG8_STAGE(PG8_SB(0, 0), cB, voffB); PG8_STAGE(PG8_SB(0, 1), cB + hstep, voffB); PG8_STAGE(PG8_SA(0, 0), cA, voffA); PG8_STAGE(PG8_SA(0, 1), cA + hstep, voffA);
        if (wr == 1) PG8_BAR;
        PG8_WAIT_V(2); PG8_BAR;
        PG8_STAGE(PG8_SB(1, 0), cB + kstep, voffB); PG8_STAGE(PG8_SA(1, 0), cA + kstep, voffA); PG8_STAGE(PG8_SB(1, 1), cB + hstep + kstep, voffB);
        PG8_WAIT_V(6); PG8_BAR;
    } else {
        PG8_STAGE(PG8_SB(0, 0), cB, voffB); PG8_STAGE(PG8_SA(0, 0), cA, voffA); PG8_STAGE(PG8_SB(0, 1), cB + hstep, voffB); PG8_STAGE(PG8_SA(0, 1), cA + hstep, voffA);
        if (wr == 1) PG8_BAR;
        PG8_WAIT_V(4); PG8_BAR;
        PG8_STAGE(PG8_SB(1, 0), cB + kstep, voffB); PG8_STAGE(PG8_SA(1, 0), cA + kstep, voffA); PG8_STAGE(PG8_SB(1, 1), cB + hstep + kstep, voffB);
        PG8_WAIT_V(6); PG8_BAR;
    }
    for (;;) {
        const bool has_next = S.next(ui + 1, nxt);
        const char* nA = has_next ? (const char*)g.A + (size_t)nxt.pm * tstep : cA; const char* nB = has_next ? (const char*)g.Bt + (size_t)nxt.pn * tstep : cB;
        for (int t = 0; t < nt; t += 2) {
            const bool last = (t == nt - 2);
            const char* a1 = cA + (size_t)(t + 1) * kstep;
            const char* a2 = last ? nA : cA + (size_t)(t + 2) * kstep; const char* b2 = last ? nB : cB + (size_t)(t + 2) * kstep;
            const char* a3 = a2 + kstep; const char* b3 = b2 + kstep;
            if (last && has_next) S.a_ready(nxt);
            if constexpr (SP2) {
            PG8_LDB(B0, 0, 0); PG8_LDB(B1, 0, 1); PG8_SCHED; PG8_LDA(At, 0, 0); PG8_STAGE(PG8_SA(1, 1), a1 + hstep, voffA);
            PG8_WAIT_V(8); PG8_WAIT_L(0); PG8_BAR; PG8_MMA(0, 0, At, B0); PG8_MMA(0, 1, At, B1); PG8_BAR; PG8_SCHED;
            PG8_LDA(At, 0, 1); PG8_STAGE(PG8_SB(0, 0), b2, voffB); PG8_STAGE(PG8_SB(0, 1), b2 + hstep, voffB); PG8_STAGE(PG8_SA(0, 0), a2, voffA);
            PG8_WAIT_V(8); PG8_WAIT_L(0); PG8_BAR; PG8_MMA(1, 0, At, B0); PG8_MMA(1, 1, At, B1); PG8_BAR; PG8_SCHED;
            PG8_LDB(B0, 1, 0); PG8_LDB(B1, 1, 1); PG8_SCHED; PG8_LDA(At, 1, 0); PG8_STAGE(PG8_SA(0, 1), a2 + hstep, voffA);
            PG8_WAIT_V(8); PG8_WAIT_L(0); PG8_BAR; PG8_MMA(0, 0, At, B0); PG8_MMA(0, 1, At, B1); PG8_BAR; PG8_SCHED;
            PG8_LDA(At, 1, 1); PG8_STAGE(PG8_SB(1, 0), b3, voffB); PG8_STAGE(PG8_SB(1, 1), b3 + hstep, voffB); PG8_STAGE(PG8_SA(1, 0), a3, voffA);
            PG8_WAIT_V(8); PG8_WAIT_L(0); PG8_BAR; PG8_MMA(1, 0, At, B0); PG8_MMA(1, 1, At, B1); PG8_BAR; PG8_SCHED;
            } else {
            PG8_LDB(B0, 0, 0); PG8_SCHED; PG8_LDA(At, 0, 0); PG8_STAGE(PG8_SA(1, 1), a1 + hstep, voffA);
            PG8_WAIT_L(8); PG8_BAR; PG8_WAIT_L(0); PG8_MMA(0, 0, At, B0); PG8_BAR; PG8_SCHED;
            PG8_LDB(B1, 0, 1); PG8_STAGE(PG8_SB(0, 0), b2, voffB);
            PG8_BAR; PG8_WAIT_L(0); PG8_MMA(0, 1, At, B1); PG8_BAR;
            PG8_LDA(At, 0, 1); PG8_STAGE(PG8_SA(0, 0), a2, voffA);
            PG8_BAR; PG8_WAIT_L(0); PG8_MMA(1, 0, At, B0); PG8_BAR; PG8_SCHED;
            PG8_STAGE(PG8_SB(0, 1), b2 + hstep, voffB);
            PG8_WAIT_V(6); PG8_BAR; PG8_MMA(1, 1, At, B1); PG8_BAR;
            PG8_LDB(B0, 1, 0); PG8_SCHED; PG8_LDA(At, 1, 0); PG8_STAGE(PG8_SA(0, 1), a2 + hstep, voffA);
            PG8_WAIT_L(8); PG8_BAR; PG8_WAIT_L(0); PG8_MMA(0, 0, At, B0); PG8_BAR; PG8_SCHED;
            PG8_LDB(B1, 1, 1); PG8_STAGE(PG8_SB(1, 0), b3, voffB);
            PG8_BAR; PG8_WAIT_L(0); PG8_MMA(0, 1, At, B1); PG8_BAR;
            PG8_LDA(At, 1, 1); PG8_STAGE(PG8_SA(1, 0), a3, voffA);
            PG8_BAR; PG8_WAIT_L(0); PG8_MMA(1, 0, At, B0); PG8_BAR; PG8_SCHED;
            PG8_STAGE(PG8_SB(1, 1), b3 + hstep, voffB);
            PG8_WAIT_V(6); PG8_BAR; PG8_MMA(1, 1, At, B1); PG8_BAR;
            }
        }
        if constexpr (ALIGN_EPI) { if (wr == 0) PG8_BAR; }
        if constexpr (!Epi::AFTER_DRAIN) { E(acc, cur, wr, wc, fr, fq); S.done(cur); }
        if (!has_next) break;
#pragma unroll
        for (int a = 0; a < 2; ++a)
#pragma unroll
            for (int b = 0; b < 2; ++b)
#pragma unroll
                for (int m = 0; m < 4; ++m)
#pragma unroll
                    for (int n = 0; n < 2; ++n) acc[a][b][m][n] = (f32x4){0.f, 0.f, 0.f, 0.f};
        cur = nxt; cA = nA; cB = nB; ++ui;
        if constexpr (ALIGN_EPI) { if (wr == 1) PG8_BAR; }
    }
    PG8_WAIT_V(0);
    if constexpr (!ALIGN_EPI) { if (wr == 0) PG8_BAR; }
    PG8_BAR;
    if constexpr (Epi::AFTER_DRAIN) { E.fused(acc, cur, wr, wc, fr, fq, lds, wid, lane); S.done(cur); }
#undef PG8_SA
#undef PG8_SB
#undef PG8_STAGE
#undef PG8_LDA
#undef PG8_LDB
#undef PG8_MMA
#undef PG8_WAIT_V
#undef PG8_WAIT_L
#undef PG8_BAR
#undef PG8_SCHED
}
}

#define DI __device__ __forceinline__
#define LAS __attribute__((address_space(3)))
typedef unsigned short bf16_t;
typedef short bf16x8 __attribute__((ext_vector_type(8)));
typedef short s16x4 __attribute__((ext_vector_type(4)));
typedef float f32x4 __attribute__((ext_vector_type(4)));
typedef float f32x16 __attribute__((ext_vector_type(16)));
typedef unsigned u32x4 __attribute__((ext_vector_type(4)));
typedef unsigned u32x2 __attribute__((ext_vector_type(2)));
typedef float f32x2_t __attribute__((ext_vector_type(2)));
typedef __bf16 bf16x2_t __attribute__((ext_vector_type(2)));
typedef short v4i16_t __attribute__((ext_vector_type(4)));

constexpr int NTHREADS = 512, NWAVES = 8;
constexpr int BATCH = 8, SEQ = 2048, DM = 1024, NH = 16, HD = 64, MTOK = BATCH * SEQ;
constexpr int FOX_IN = 4 * DM + NH, DSW_IN = 10 * DM;
constexpr float EPS = 1e-6f;
constexpr float LOG2E = 1.4426950408889634f;
constexpr float C2 = 0.125f * LOG2E;
constexpr int LDS_BYTES = 147456;

constexpr size_t MiB = 1u << 20;
constexpr size_t WS_CTL = 0, CTL_ZERO_BYTES = 16384;
constexpr size_t WS_ROT = 1 * MiB;
constexpr size_t WS_SSQ = 2 * MiB;
constexpr size_t WS_CLOC = 3 * MiB;
constexpr size_t WS_CTOT = 4 * MiB;
constexpr size_t WS_WF = 5 * MiB;
constexpr size_t WS_WFOX = 8 * MiB;
constexpr size_t WS_WDSW = 24 * MiB;
constexpr size_t WS_WOUT = 64 * MiB;
constexpr size_t WS_XB = 72 * MiB;
constexpr size_t WS_AO = 104 * MiB;
constexpr size_t WS_PROJ = 136 * MiB;
constexpr size_t WS_END = 296 * MiB;

DI unsigned cvtpk(float lo, float hi) { f32x2_t v = {lo, hi}; bf16x2_t b = __builtin_convertvector(v, bf16x2_t); return __builtin_bit_cast(unsigned, b); }
DI float bf_lo(unsigned w) { return __uint_as_float(w << 16); }
DI float bf_hi(unsigned w) { return __uint_as_float(w & 0xffff0000u); }
DI float fexp2(float x) { return __builtin_amdgcn_exp2f(x); }
DI float silu(float g) { return g / (1.f + __expf(-g)); }
DI s16x4 vtr(const void* p) { return __builtin_bit_cast(s16x4, __builtin_amdgcn_ds_read_tr16_b64_v4i16((LAS v4i16_t*)p)); }
DI int crow(int i, int hi) { return (i & 3) + 8 * (i >> 2) + 4 * hi; }
#define MFMA32(a, b, c) __builtin_amdgcn_mfma_f32_32x32x16_bf16((a), (b), (c), 0, 0, 0)
DI bf16x8 pack8(float a0, float a1, float a2, float a3, float a4, float a5, float a6, float a7) {
    u32x4 w; w.x = cvtpk(a0, a1); w.y = cvtpk(a2, a3); w.z = cvtpk(a4, a5); w.w = cvtpk(a6, a7); return __builtin_bit_cast(bf16x8, w);
}

struct EpiProj {
    static constexpr bool PERM = true, AFTER_DRAIN = false;
    bf16_t* out; size_t mats;
    const float* ssq; const float* rot; int row_off;
    const float* qg; const float* kg; int nq;
    DI void operator()(const f32x4 (&acc)[2][2][4][2], const pg8::Unit& u, int wr, int wc, int fr, int fq) const {
        const int mat = u.pn >> 2, head = (u.pn & 3) * 4 + wc;
        const int kind = mat < nq ? 1 : (mat < 2 * nq ? 2 : 0);
        const float* gp = kind == 1 ? qg + 64 * mat : kg + 64 * (mat - nq);
        f32x4 gn[2][2];
#pragma unroll
        for (int bj = 0; bj < 2; ++bj)
#pragma unroll
            for (int n = 0; n < 2; ++n) gn[bj][n] = kind ? *(const f32x4*)(gp + 32 * bj + 8 * fq + 4 * n) : (f32x4){1.f, 1.f, 1.f, 1.f};
        const float qs = kind == 1 ? C2 : 1.f;
        bf16_t* obase = out + (size_t)mat * mats + head * 64 + 8 * fq;
        const bool rotl = (nq == 3) && kind && fq < 2;
        float rstd[8];
#pragma unroll
        for (int hb = 0; hb < 2; ++hb) {
            f32x4 sp[4];
#pragma unroll
            for (int r = 0; r < 4; ++r) { const int row = u.pm * 256 + hb * 128 + wr * 64 + r * 16 + fr; sp[r] = *(const f32x4*)(ssq + (size_t)(row_off + row) * 16 + 4 * fq); }
#pragma unroll
            for (int r = 0; r < 4; ++r) { float t = (sp[r][0] + sp[r][1]) + (sp[r][2] + sp[r][3]); t += __shfl_xor(t, 16); t += __shfl_xor(t, 32); rstd[4 * hb + r] = rsqrtf(t * (1.f / DM) + EPS); }
        }
        f32x4 rc0 = {}, rc1 = {}, rs0 = {}, rs1 = {};
        if (rotl) { const float* rp = rot + (size_t)(row_off + u.pm * 256 + wr * 64 + fr) * 16; rc0 = *(const f32x4*)rp; rc1 = *(const f32x4*)(rp + 4); rs0 = *(const f32x4*)(rp + 8); rs1 = *(const f32x4*)(rp + 12); }
#pragma unroll
        for (int r = 0; r < 8; ++r) {
            const int ai = r >> 2, m = r & 3;
            const int row = u.pm * 256 + ai * 128 + wr * 64 + m * 16 + fr;
            const f32x4 c0 = rc0, c1 = rc1, s0 = rs0, s1 = rs1;
            if (rotl && r < 7) { const int rn = u.pm * 256 + ((r + 1) >> 2) * 128 + wr * 64 + ((r + 1) & 3) * 16 + fr; const float* rp = rot + (size_t)(row_off + rn) * 16;
                rc0 = *(const f32x4*)rp; rc1 = *(const f32x4*)(rp + 4); rs0 = *(const f32x4*)(rp + 8); rs1 = *(const f32x4*)(rp + 12); }
            f32x4 v[2][2];
#pragma unroll
            for (int bj = 0; bj < 2; ++bj)
#pragma unroll
                for (int n = 0; n < 2; ++n) v[bj][n] = acc[ai][bj][m][n] * rstd[r];
            if (kind) {
                float ss = 0.f;
#pragma unroll
                for (int bj = 0; bj < 2; ++bj)
#pragma unroll
                    for (int n = 0; n < 2; ++n) ss += (v[bj][n][0] * v[bj][n][0] + v[bj][n][1] * v[bj][n][1]) + (v[bj][n][2] * v[bj][n][2] + v[bj][n][3] * v[bj][n][3]);
                ss += __shfl_xor(ss, 16); ss += __shfl_xor(ss, 32);
                const float hr = rsqrtf(ss * (1.f / HD) + EPS) * qs;
#pragma unroll
                for (int bj = 0; bj < 2; ++bj)
#pragma unroll
                    for (int n = 0; n < 2; ++n) v[bj][n] = v[bj][n] * gn[bj][n] * hr;
                if (nq == 3) {
                    f32x4 o0, o1;
#pragma unroll
                    for (int e = 0; e < 4; ++e) { o0[e] = __shfl_xor(v[0][0][e], 16); o1[e] = __shfl_xor(v[0][1][e], 16); }
                    if (fq == 0) { v[0][0] = v[0][0] * c0 - o0 * s0; v[0][1] = v[0][1] * c1 - o1 * s1; }
                    else if (fq == 1) { v[0][0] = v[0][0] * c0 + o0 * s0; v[0][1] = v[0][1] * c1 + o1 * s1; }
                }
            }
            int prow = row;
            if (nq == 3 && mat < 9) { const int gi = mat % 3;
                if (gi == 1) prow = (row & ~511) + ((row & 3) << 7) + ((row & 511) >> 2);
                else if (gi == 2) prow = (row & ~511) + ((row & 15) << 5) + ((row & 511) >> 4); }
            bf16_t* rowp = obase + (size_t)prow * DM;
#pragma unroll
            for (int bj = 0; bj < 2; ++bj) {
                u32x4 w; w.x = cvtpk(v[bj][0][0], v[bj][0][1]); w.y = cvtpk(v[bj][0][2], v[bj][0][3]); w.z = cvtpk(v[bj][1][0], v[bj][1][1]); w.w = cvtpk(v[bj][1][2], v[bj][1][3]);
                *(u32x4*)(rowp + 32 * bj) = w;
            }
        }
    }
};

struct EpiOut {
    static constexpr bool PERM = false, AFTER_DRAIN = false;
    const float* xin; float* xout; bf16_t* xb; float* ssq; int last;
    DI void operator()(const f32x4 (&acc)[2][2][4][2], const pg8::Unit& u, int wr, int wc, int fr, int fq) const {
        const int col0 = u.pn * 256 + wc * 32 + 4 * fq;
#pragma unroll
        for (int ai = 0; ai < 2; ++ai)
#pragma unroll
            for (int m = 0; m < 4; ++m) {
                const size_t row = (size_t)(u.pm * 256 + ai * 128 + wr * 64 + m * 16 + fr);
                float ss = 0.f;
#pragma unroll
                for (int bj = 0; bj < 2; ++bj)
#pragma unroll
                    for (int n = 0; n < 2; ++n) {
                        const size_t off = row * DM + col0 + bj * 128 + n * 16;
                        const f32x4 xo = *(const f32x4*)(xin + off) + acc[ai][bj][m][n];
                        *(f32x4*)(xout + off) = xo;
                        if (!last) { u32x2 w; w.x = cvtpk(xo[0], xo[1]); w.y = cvtpk(xo[2], xo[3]); *(u32x2*)(xb + off) = w; }
                        ss += (xo[0] * xo[0] + xo[1] * xo[1]) + (xo[2] * xo[2] + xo[3] * xo[3]);
                    }
                ss += __shfl_xor(ss, 16); ss += __shfl_xor(ss, 32);
                if (fq == 0 && !last) ssq[row * 16 + u.pn * 4 + wc] = ss;
            }
    }
};

DI float wave_sum(float v) {
#pragma unroll
    for (int o = 1; o < 64; o <<= 1) v += __shfl_xor(v, o);
    return v;
}
DI void transpose_item(const float* W, int ldw, int N, bf16_t* WT, const float* gain, bool perm, float* scr, int item, int lane) {
    const int nblk = N / 32, kb = item / nblk, nb = item % nblk, k0 = 64 * kb, n0 = 32 * nb;
    const int c0 = perm ? ((n0 & ~255) + 64 * ((n0 >> 5) & 3) + 32 * ((n0 >> 7) & 1)) : n0;
    {
        f32x4 w[8];
#pragma unroll
        for (int i = 0; i < 8; ++i) w[i] = *(const f32x4*)(W + (size_t)(k0 + 8 * i + (lane >> 3)) * ldw + c0 + 4 * (lane & 7));
#pragma unroll
        for (int i = 0; i < 8; ++i) { const int kk = 8 * i + (lane >> 3); const float g = gain ? gain[k0 + kk] : 1.f; float* d = scr + kk * 33 + 4 * (lane & 7);
            d[0] = w[i][0] * g; d[1] = w[i][1] * g; d[2] = w[i][2] * g; d[3] = w[i][3] * g; }
    }
    const int c = lane & 7;
#pragma unroll
    for (int j = 0; j < 4; ++j) { const int n = (lane >> 3) + 8 * j; const float* s = scr + (8 * c) * 33 + n;
        u32x4 o; o.x = cvtpk(s[0 * 33], s[1 * 33]); o.y = cvtpk(s[2 * 33], s[3 * 33]); o.z = cvtpk(s[4 * 33], s[5 * 33]); o.w = cvtpk(s[6 * 33], s[7 * 33]);
        *(u32x4*)(WT + (size_t)(n0 + n) * DM + k0 + 8 * c) = o; }
}

struct Args {
    const float* x; const int* pos; const float* norm_g; const float* fox_w_in; const float* fox_b_f; const float* fox_qn; const float* fox_kn; const float* fox_w_out;
    const float* dsw_w_in; const float* dsw_qn; const float* dsw_kn; const float* dsw_w_out; float* out; unsigned char* ws;
};

DI void prologue(const Args& a, unsigned char* lds) {
    const int tid = mk_tid(), lane = tid & 63, wave = tid >> 6;
    const int gw = blockIdx.x * NWAVES + wave, NGW = gridDim.x * NWAVES;
    float* scr = (float*)(lds + wave * 8448);
    unsigned char* ws = a.ws;
    constexpr int I_FOX = 16 * (4096 / 32), I_DSW = 16 * (10240 / 32), I_OUT = 16 * (1024 / 32);
    constexpr int NITEMS = 2 * I_FOX + 2 * I_DSW + 4 * I_OUT;
    for (int it = gw; it < NITEMS; it += NGW) {
        int r = it;
        if (r < 2 * I_FOX) { const int j = r / I_FOX; transpose_item(a.fox_w_in + (size_t)j * DM * FOX_IN, FOX_IN, 4096, (bf16_t*)(ws + WS_WFOX) + (size_t)j * 4096 * DM, a.norm_g + 2 * j * DM, true, scr, r % I_FOX, lane); continue; }
        r -= 2 * I_FOX;
        if (r < 2 * I_DSW) { const int j = r / I_DSW; transpose_item(a.dsw_w_in + (size_t)j * DM * DSW_IN, DSW_IN, 10240, (bf16_t*)(ws + WS_WDSW) + (size_t)j * 10240 * DM, a.norm_g + (2 * j + 1) * DM, true, scr, r % I_DSW, lane); continue; }
        r -= 2 * I_DSW;
        { const int L = r / I_OUT, j = L >> 1; const float* W = (L & 1) ? a.dsw_w_out + (size_t)j * DM * DM : a.fox_w_out + (size_t)j * DM * DM;
          transpose_item(W, DM, 1024, (bf16_t*)(ws + WS_WOUT) + (size_t)L * DM * DM, nullptr, false, scr, r % I_OUT, lane); }
    }
    { bf16_t* wf = (bf16_t*)(ws + WS_WF);
      for (int e = blockIdx.x * NTHREADS + tid; e < 2 * 16 * DM; e += gridDim.x * NTHREADS) {
          const int j = e >> 14, h = (e >> 10) & 15, k = e & 1023;
          const float v = a.norm_g[2 * j * DM + k] * a.fox_w_in[(size_t)j * DM * FOX_IN + (size_t)k * FOX_IN + 4096 + h];
          const unsigned hi = cvtpk(v, 0.f) & 0xffffu; const float r = v - __uint_as_float(hi << 16);
          wf[(size_t)(j * 2 + 0) * 16 * DM + h * DM + k] = (bf16_t)hi; wf[(size_t)(j * 2 + 1) * 16 * DM + h * DM + k] = (bf16_t)(cvtpk(r, 0.f) & 0xffffu); } }
    { float* rot = (float*)(ws + WS_ROT);
      const double invf[8] = {1.0, 0.19392274474868576, 0.03760603093086393, 0.007292664737217109, 0.001414213562373095, 0.0002742481756762073, 5.318295896944988e-05, 1.031338537721246e-05};
      for (int e = blockIdx.x * NTHREADS + tid; e < MTOK * 8; e += gridDim.x * NTHREADS) {
          const int t = e >> 3, i = e & 7;
          double f = 1.0;
#pragma unroll
          for (int q = 0; q < 8; ++q) f = (i == q) ? invf[q] : f;
          const double ang = (double)a.pos[t] * f;
          const double k2 = __builtin_rint(ang * 0.15915494309189535);
          const float r = (float)(ang - k2 * 6.283185307179586);
          rot[(size_t)t * 16 + i] = cosf(r); rot[(size_t)t * 16 + 8 + i] = sinf(r); } }
    { bf16_t* xb = (bf16_t*)(ws + WS_XB); float* ssq = (float*)(ws + WS_SSQ);
      for (int m = gw; m < MTOK; m += 2 * NGW) {
          const int m2 = m + NGW; const bool two = m2 < MTOK;
          const f32x4* xr = (const f32x4*)(a.x + (size_t)m * DM) + lane; const f32x4* xr2 = (const f32x4*)(a.x + (size_t)(two ? m2 : m) * DM) + lane;
          f32x4 v[4], w2[4];
#pragma unroll
          for (int j = 0; j < 4; ++j) { v[j] = xr[64 * j]; w2[j] = xr2[64 * j]; }
          float s = 0.f, s2 = 0.f;
#pragma unroll
          for (int j = 0; j < 4; ++j) { s += (v[j][0] * v[j][0] + v[j][1] * v[j][1]) + (v[j][2] * v[j][2] + v[j][3] * v[j][3]); s2 += (w2[j][0] * w2[j][0] + w2[j][1] * w2[j][1]) + (w2[j][2] * w2[j][2] + w2[j][3] * w2[j][3]);
              u32x2 w; w.x = cvtpk(v[j][0], v[j][1]); w.y = cvtpk(v[j][2], v[j][3]); *((u32x2*)(xb + (size_t)m * DM) + lane + 64 * j) = w;
              if (two) { u32x2 q; q.x = cvtpk(w2[j][0], w2[j][1]); q.y = cvtpk(w2[j][2], w2[j][3]); *((u32x2*)(xb + (size_t)m2 * DM) + lane + 64 * j) = q; } }
          s = wave_sum(s); s2 = wave_sum(s2);
          if (lane < 16) { ssq[(size_t)m * 16 + lane] = lane == 0 ? s : 0.f; if (two) ssq[(size_t)m2 * 16 + lane] = lane == 0 ? s2 : 0.f; }
      } }
}

DI void fg_step(const float* x, const bf16_t* wf, const float* b_f, float* cloc, float* ctot, unsigned char* lds) {
    const int tid = mk_tid(), lane = tid & 63, wave = tid >> 6;
    float* ls = (float*)lds;
    float* part = (float*)(lds + 4096);
    for (int chunk = blockIdx.x; chunk < MTOK / 64; chunk += gridDim.x) {
        {
            const int tile = wave & 3, kh = wave >> 2;
            const int row = lane & 15, kg = lane >> 4; const size_t tok = (size_t)chunk * 64 + tile * 16 + row;
            const float* xp = x + tok * DM + 512 * kh + 8 * kg; const bf16_t* wh = wf + (size_t)row * DM + 512 * kh + 8 * kg; const bf16_t* wl = wh + 16 * DM;
            f32x4 acc = {0.f, 0.f, 0.f, 0.f}; float ss = 0.f;
#pragma unroll 8
            for (int s = 0; s < 16; ++s) {
                const f32x4 a0 = *(const f32x4*)(xp + 32 * s), a1 = *(const f32x4*)(xp + 32 * s + 4);
                ss += (a0[0] * a0[0] + a0[1] * a0[1]) + (a0[2] * a0[2] + a0[3] * a0[3]) + (a1[0] * a1[0] + a1[1] * a1[1]) + (a1[2] * a1[2] + a1[3] * a1[3]);
                u32x4 h; h.x = cvtpk(a0[0], a0[1]); h.y = cvtpk(a0[2], a0[3]); h.z = cvtpk(a1[0], a1[1]); h.w = cvtpk(a1[2], a1[3]);
                u32x4 l; l.x = cvtpk(a0[0] - bf_lo(h.x), a0[1] - bf_hi(h.x)); l.y = cvtpk(a0[2] - bf_lo(h.y), a0[3] - bf_hi(h.y));
                l.z = cvtpk(a1[0] - bf_lo(h.z), a1[1] - bf_hi(h.z)); l.w = cvtpk(a1[2] - bf_lo(h.w), a1[3] - bf_hi(h.w));
                const bf16x8 ah = __builtin_bit_cast(bf16x8, h), al = __builtin_bit_cast(bf16x8, l);
                const bf16x8 bh = *(const bf16x8*)(wh + 32 * s), bl = *(const bf16x8*)(wl + 32 * s);
                acc = __builtin_amdgcn_mfma_f32_16x16x32_bf16(ah, bh, acc, 0, 0, 0);
                acc = __builtin_amdgcn_mfma_f32_16x16x32_bf16(ah, bl, acc, 0, 0, 0);
                acc = __builtin_amdgcn_mfma_f32_16x16x32_bf16(al, bh, acc, 0, 0, 0);
            }
            if (kh == 1) { float* pp = part + (tile * 64 + lane) * 5; pp[0] = acc[0]; pp[1] = acc[1]; pp[2] = acc[2]; pp[3] = acc[3]; pp[4] = ss; }
            __syncthreads();
            if (kh == 0) {
                const float* pp = part + (tile * 64 + lane) * 5;
                acc[0] += pp[0]; acc[1] += pp[1]; acc[2] += pp[2]; acc[3] += pp[3]; ss += pp[4];
                ss += __shfl_xor(ss, 16); ss += __shfl_xor(ss, 32);
                const float rstd = rsqrtf(ss * (1.f / DM) + EPS);
                const float bf = b_f[lane & 15];
#pragma unroll
                for (int i = 0; i < 4; ++i) {
                    const int t = 4 * kg + i; const float rs = __shfl(rstd, t);
                    const float f = acc[i] * rs + bf;
                    const float v = fminf(f, 0.f) - log1pf(__expf(-fabsf(f)));
                    ls[(tile * 16 + t) * 16 + (lane & 15)] = v;
                }
            }
        }
        __syncthreads();
#pragma unroll
        for (int hh = 0; hh < 2; ++hh) {
            const int head = 2 * wave + hh; float v = ls[lane * 16 + head];
#pragma unroll
            for (int o = 1; o < 64; o <<= 1) { const float t = __shfl_up(v, o); if (lane >= o) v += t; }
            cloc[((size_t)chunk * 64 + lane) * 16 + head] = v;
            if (lane == 63) ctot[(size_t)chunk * 16 + head] = v;
        }
        __syncthreads();
    }
}

DI float xhalf_max(float m) { auto rr = __builtin_amdgcn_permlane32_swap(__float_as_uint(m), __float_as_uint(m), false, false); return fmaxf(__uint_as_float(rr[0]), __uint_as_float(rr[1])); }
DI float max3f(float a, float b, float c) { return fmaxf(fmaxf(a, b), c); }
DI float max2f(float a, float b) { return fmaxf(a, b); }
DI float sub_f(float a, float b) { return a - b; }
DI float add_f(float a, float b) { return a + b; }
DI float mul_f(float a, float b) { return a * b; }
DI float exp_sum16(f32x16& p, float mx) {
    float s0 = 0.f, s1 = 0.f;
#pragma unroll
    for (int i = 0; i < 16; i += 2) { p[i] = fexp2(sub_f(p[i], mx)); p[i + 1] = fexp2(sub_f(p[i + 1], mx)); s0 = add_f(s0, p[i]); s1 = add_f(s1, p[i + 1]); }
    return s0 + s1;
}
DI void scale16(f32x16& o, float a) {
#pragma unroll
    for (int i = 0; i < 16; ++i) o[i] = mul_f(o[i], a);
}

constexpr int FA_ROWB = 144;
constexpr int FA_K = 0, FA_V = 64 * FA_ROWB, FA_BIAS = 2 * 64 * FA_ROWB, FA_BUF = FA_BIAS + 256;
constexpr int FA_PRE = 2 * FA_BUF;

#define LDS_BAR() do { asm volatile("s_waitcnt lgkmcnt(0)" ::: "memory"); __builtin_amdgcn_s_barrier(); asm volatile("" ::: "memory"); } while (0)
DI void fox_compute(const unsigned char* cur, int t, int NT, int qpos, const bf16x8 (&qr)[4], f32x16& o0, f32x16& o1, float& mrow, float& lsum, int r32, int hi, int trb) {
    f32x16 p0, p1;
    { const float* bias = (const float*)(cur + FA_BIAS) + 4 * hi;
#pragma unroll
      for (int g = 0; g < 4; ++g) { const f32x4 b0 = *(const f32x4*)(bias + 8 * g), b1 = *(const f32x4*)(bias + 32 + 8 * g);
#pragma unroll
          for (int e = 0; e < 4; ++e) { p0[4 * g + e] = b0[e]; p1[4 * g + e] = b1[e]; } } }
    { const unsigned char* kb = cur + FA_K + r32 * FA_ROWB + 16 * hi;
      bf16x8 kf0[4], kf1[4];
#pragma unroll
      for (int s = 0; s < 4; ++s) { kf0[s] = *(const bf16x8*)(kb + 32 * s); kf1[s] = *(const bf16x8*)(kb + 32 * FA_ROWB + 32 * s); }
      __builtin_amdgcn_s_setprio(1);
#pragma unroll
      for (int s = 0; s < 4; ++s) { p0 = MFMA32(kf0[s], qr[s], p0); p1 = MFMA32(kf1[s], qr[s], p1); }
      __builtin_amdgcn_s_setprio(0); }
    if (t >= NT - 4) {
        asm volatile("" ::: "memory");
        const int kb0 = 64 * t;
#pragma unroll
        for (int i = 0; i < 16; ++i) { const int kv = kb0 + crow(i, hi); if (kv > qpos) p0[i] = -INFINITY; if (kv + 32 > qpos) p1[i] = -INFINITY; }
    }
    float ma = mrow, mb = max2f(p0[0], p1[0]);
#pragma unroll
    for (int i = 1; i < 16; i += 2) { ma = max3f(ma, p0[i], p1[i]); if (i + 1 < 16) mb = max3f(mb, p0[i + 1], p1[i + 1]); }
    float mx = max2f(ma, mb);
    mx = xhalf_max(mx);
    const float alpha = fexp2(mrow - mx); mrow = mx;
    const float rs = exp_sum16(p0, mx) + exp_sum16(p1, mx);
    lsum = lsum * alpha + rs;
    if (__builtin_amdgcn_ballot_w64(alpha != 1.f) != 0ull) {
        scale16(o0, alpha); scale16(o1, alpha);
    }
    const bf16x8 pf0 = pack8(p0[0], p0[1], p0[2], p0[3], p0[4], p0[5], p0[6], p0[7]), pf1 = pack8(p0[8], p0[9], p0[10], p0[11], p0[12], p0[13], p0[14], p0[15]);
    const bf16x8 pf2 = pack8(p1[0], p1[1], p1[2], p1[3], p1[4], p1[5], p1[6], p1[7]), pf3 = pack8(p1[8], p1[9], p1[10], p1[11], p1[12], p1[13], p1[14], p1[15]);
    const unsigned char* vb = cur + FA_V + trb;
#pragma unroll
    for (int ks = 0; ks < 4; ++ks) {
        const bf16x8 pf = ks == 0 ? pf0 : (ks == 1 ? pf1 : (ks == 2 ? pf2 : pf3));
        const s16x4 a0l = vtr(vb + ks * 16 * FA_ROWB), a0h = vtr(vb + (ks * 16 + 8) * FA_ROWB);
        const s16x4 a1l = vtr(vb + ks * 16 * FA_ROWB + 64), a1h = vtr(vb + (ks * 16 + 8) * FA_ROWB + 64);
        const bf16x8 va0 = __builtin_shufflevector(a0l, a0h, 0, 1, 2, 3, 4, 5, 6, 7), va1 = __builtin_shufflevector(a1l, a1h, 0, 1, 2, 3, 4, 5, 6, 7);
        o0 = MFMA32(va0, pf, o0); o1 = MFMA32(va1, pf, o1);
    }
}

DI void fox_unit(unsigned char* lds, int b, int h, int qb, const bf16_t* Q, const bf16_t* K, const bf16_t* V, const bf16_t* G, bf16_t* AO, const float* cloc, const float* ctot, const float* qn, const float* kn) {
    const int tid = mk_tid(), lane = tid & 63, wid = __builtin_amdgcn_readfirstlane(tid >> 6), r32 = lane & 31, hi = lane >> 5;
    const size_t rowbase = (size_t)b * SEQ; const int q0 = qb * 256, NT = 4 * (qb + 1);
    float* pre = (float*)(lds + FA_PRE);
    if (wid == 0) {
        float v = lane < 32 ? ctot[((size_t)b * 32 + (lane & 31)) * 16 + h] : 0.f; float inc = v;
#pragma unroll
        for (int o = 1; o < 32; o <<= 1) { const float t = __shfl_up(inc, o); if (lane >= o) inc += t; }
        if (lane < 32) pre[lane] = inc - v;
    }
    float qkB;
    { float gq = fabsf(qn[lane]), gk = fabsf(kn[lane]);
#pragma unroll
      for (int o = 1; o < 64; o <<= 1) { gq = fmaxf(gq, __shfl_xor(gq, o)); gk = fmaxf(gk, __shfl_xor(gk, o)); }
      qkB = 64.f * C2 * gq * gk * 1.02f; }
    float* red = (float*)(lds + FA_PRE + 128);
    const int key = tid >> 3, ch = tid & 7;
    const bf16_t* kp = K + (rowbase + key) * DM + h * HD + ch * 8; const bf16_t* vp = V + (rowbase + key) * DM + h * HD + ch * 8;
    const float* cp = cloc + (rowbase + (tid & 63)) * 16 + h;
    bf16x8 qr[4];
    const int qpos = q0 + 32 * wid + r32;
    { const bf16_t* qp = Q + (rowbase + qpos) * DM + h * HD + 8 * hi;
#pragma unroll
      for (int s = 0; s < 4; ++s) qr[s] = *(const bf16x8*)(qp + 16 * s); }
    u32x2 gw8[2][4];
    { const size_t orow_ = (rowbase + qpos) * DM + h * HD + 4 * hi;
#pragma unroll
      for (int mt = 0; mt < 2; ++mt)
#pragma unroll
          for (int g = 0; g < 4; ++g) gw8[mt][g] = *(const u32x2*)(G + orow_ + 32 * mt + 8 * g); }
    u32x4 kA, vA, kB, vB, kC, vC, kD, vD; float cA, cB, cC, cD;
#define FOX_LOAD(t_, kx, vx, cx) do { const int tc_ = (t_) < NT ? NT - 1 - (t_) : 0; const size_t adv_ = (size_t)tc_ * 64 * DM; kx = *(const u32x4*)(kp + adv_); vx = *(const u32x4*)(vp + adv_); cx = cp[(size_t)tc_ * 64 * 16]; } while (0)
#define FOX_WRITE(t_, kx, vx, cx) do { unsigned char* bw_ = lds + ((t_) & 1) * FA_BUF; *(u32x4*)(bw_ + FA_K + key * FA_ROWB + ch * 16) = kx; *(u32x4*)(bw_ + FA_V + key * FA_ROWB + ch * 16) = vx; \
        if (tid < 64) ((float*)(bw_ + FA_BIAS))[tid] = -(cx + pre[NT - 1 - (t_)]) * LOG2E; } while (0)
    FOX_LOAD(0, kA, vA, cA); FOX_LOAD(1, kB, vB, cB); FOX_LOAD(2, kC, vC, cC); FOX_LOAD(3, kD, vD, cD);
    LDS_BAR();
    FOX_WRITE(0, kA, vA, cA);
    LDS_BAR();
    f32x16 o0 = {}, o1 = {}; float mrow = -1e30f, lsum = 0.f;
    const int trb = ((lane >> 4) & 1) * 32 + (lane & 3) * 8 + (4 * hi + ((lane & 15) >> 2)) * FA_ROWB;
    const int tlast = (q0 + 32 * wid + 31) >> 6;
#define FOX_BODY(t_, kl, vl, cl, kw, vw, cw) do { \
        FOX_LOAD((t_) + 4, kl, vl, cl); \
        const bool wskip_ = (t_) >= 4 && __builtin_amdgcn_readfirstlane((int)(qkB + ((const float*)(lds + ((t_) & 1) * FA_BUF + FA_BIAS))[63] < wprev - 160.f));     \
        if (NT - 1 - (t_) <= tlast && !wskip_) fox_compute(lds + ((t_) & 1) * FA_BUF, NT - 1 - (t_), NT, qpos, qr, o0, o1, mrow, lsum, r32, hi, trb); \
        if ((t_) + 1 < NT) FOX_WRITE((t_) + 1, kw, vw, cw); \
        { float wm_ = mrow; _Pragma("unroll") for (int o_ = 1; o_ < 64; o_ <<= 1) wm_ = fminf(wm_, __shfl_xor(wm_, o_)); if (lane == 0) red[((t_) & 1) * 8 + wid] = wm_; wprev = wm_; } \
        LDS_BAR(); \
        if ((t_) >= 3 && (t_) + 1 < NT) { \
            const f32x4 r0_ = *(const f32x4*)(red + ((t_) & 1) * 8), r1_ = *(const f32x4*)(red + ((t_) & 1) * 8 + 4); \
            const float mn_ = fminf(fminf(fminf(r0_[0], r0_[1]), fminf(r0_[2], r0_[3])), fminf(fminf(r1_[0], r1_[1]), fminf(r1_[2], r1_[3]))); \
            const float bn_ = ((const float*)(lds + (((t_) + 1) & 1) * FA_BUF + FA_BIAS))[63]; \
            if (__builtin_amdgcn_readfirstlane((int)(qkB + bn_ < mn_ - 160.f))) goto fox_done; } } while (0)
    float wprev = -1e30f;
#pragma unroll 1
    for (int t = 0; t < NT; t += 4) {
        FOX_BODY(t, kA, vA, cA, kB, vB, cB);
        FOX_BODY(t + 1, kB, vB, cB, kC, vC, cC);
        FOX_BODY(t + 2, kC, vC, cC, kD, vD, cD);
        FOX_BODY(t + 3, kD, vD, cD, kA, vA, cA);
    }
fox_done:
#undef FOX_BODY
#undef FOX_LOAD
#undef FOX_WRITE
    lsum += __shfl_xor(lsum, 32);
    const float inv = 1.f / lsum;
    const size_t orow = (rowbase + qpos) * DM + h * HD + 4 * hi;
#pragma unroll
    for (int mt = 0; mt < 2; ++mt)
#pragma unroll
        for (int g = 0; g < 4; ++g) {
            const size_t off = orow + 32 * mt + 8 * g;
            const u32x2 gw = gw8[mt][g];
            const f32x16& o = mt ? o1 : o0;
            u32x2 w; w.x = cvtpk(o[4 * g] * inv * silu(bf_lo(gw.x)), o[4 * g + 1] * inv * silu(bf_hi(gw.x)));
            w.y = cvtpk(o[4 * g + 2] * inv * silu(bf_lo(gw.y)), o[4 * g + 3] * inv * silu(bf_hi(gw.y)));
            *(u32x2*)(AO + off) = w;
        }
}
DI void fox_attn_phase(unsigned char* lds, const bf16_t* proj, bf16_t* AO, const float* cloc, const float* ctot, const float* qn, const float* kn, unsigned* ctr) {
    const size_t mats = (size_t)MTOK * DM;
    volatile LAS int* slot = (volatile LAS int*)((LAS unsigned char*)lds + FA_PRE + 256);
    for (;;) {
        __syncthreads();
        if (threadIdx.x == 0) { const unsigned v = __hip_atomic_fetch_add(ctr, 1u, __ATOMIC_RELAXED, __HIP_MEMORY_SCOPE_AGENT); *slot = (int)v; }
        __syncthreads();
        const int it = __builtin_amdgcn_readfirstlane(*slot);
        if (it >= 1024) break;
        const int qb = 7 - (it >> 7), bh = it & 127, b = bh >> 4, h = bh & 15;
        fox_unit(lds, b, h, qb, proj, proj + mats, proj + 2 * mats, proj + 3 * mats, AO, cloc, ctot, qn, kn);
    }
}

constexpr int DA_OG = 0, DA_LSE2 = 2 * 256 * 128, DA_LSE = 3 * 256 * 128, DA_VST = DA_LSE + 3 * 256 * 4, DA_VROW = 144, DA_VBYTES = 32 * DA_VROW;
static_assert(DA_VST + 8 * DA_VBYTES <= 140000, "dswa LDS map");

DI void dsw_group(const bf16_t* Qh, const bf16_t* Kh, const bf16_t* Vh, int R, int cls, int e0w, int tq, int jmin, unsigned char* st, const unsigned char* kfb, int trb,
                  int lrow, int lch, int r32, int hi, f32x16& o0, f32x16& o1, float& mrow, float& lsum) {
    bf16x8 qr[4];
    const int sh = R == 1 ? 9 : (R == 4 ? 7 : 5);
#define DSW_ROW(el_) ((((el_) >> sh) << 9) + (cls << sh) + ((el_) & ((1 << sh) - 1)))
    { const bf16_t* qp = Qh + (size_t)DSW_ROW(e0w + r32) * DM + 8 * hi;
#pragma unroll
      for (int s = 0; s < 4; ++s) qr[s] = *(const bf16x8*)(qp + 16 * s); }
    o0 = f32x16{}; o1 = f32x16{}; mrow = -1e30f; lsum = 0.f;
    u32x4 kn[4], vn[4];
#define DSW_LOAD(jj_, kd, vd) do { _Pragma("unroll") for (int it_ = 0; it_ < 4; ++it_) { const size_t o_ = (size_t)DSW_ROW(e0w - 128 + 32 * (jj_) + 8 * it_ + lrow) * DM + 8 * lch; \
        kd[it_] = *(const u32x4*)(Kh + o_); vd[it_] = *(const u32x4*)(Vh + o_); } } while (0)
#define DSW_STAGE(src) do { _Pragma("unroll") for (int it_ = 0; it_ < 4; ++it_) *(u32x4*)(st + (8 * it_ + lrow) * DA_VROW + 16 * lch) = src[it_]; } while (0)
    DSW_LOAD(jmin, kn, vn);
    const int ql = r32 - 4 * hi;
#pragma unroll 1
    for (int jj = jmin; jj < 5; ++jj) {
        u32x4 kc[4], vc[4];
#pragma unroll
        for (int s = 0; s < 4; ++s) { kc[s] = kn[s]; vc[s] = vn[s]; }
        if (jj + 1 < 5) DSW_LOAD(jj + 1, kn, vn);
        DSW_STAGE(kc);
        f32x16 p = {};
        { bf16x8 kf_[4];
#pragma unroll
          for (int s = 0; s < 4; ++s) kf_[s] = *(const bf16x8*)(kfb + 32 * s);
          __builtin_amdgcn_s_setprio(1);
#pragma unroll
          for (int s = 0; s < 4; ++s) p = MFMA32(kf_[s], qr[s], p);
          __builtin_amdgcn_s_setprio(0); }
        DSW_STAGE(vc);
        if (jj == 0) {
            asm volatile("" ::: "memory");
#pragma unroll
            for (int i = 0; i < 16; ++i) p[i] = ((i & 3) + 8 * (i >> 2)) >= ql ? p[i] : -INFINITY;
        } else if (jj == 4) {
            asm volatile("" ::: "memory");
#pragma unroll
            for (int i = 0; i < 16; ++i) p[i] = ((i & 3) + 8 * (i >> 2)) <= ql ? p[i] : -INFINITY;
        }
        float ma = mrow, mb = max2f(p[0], p[1]);
#pragma unroll
        for (int i = 2; i < 16; i += 4) { ma = max3f(ma, p[i], p[i + 1]); if (i + 2 < 16) mb = max3f(mb, p[i + 2], p[i + 3]); }
        float mx = max2f(ma, mb);
        mx = xhalf_max(mx);
        const float alpha = fexp2(mrow - mx); mrow = mx;
        const float rs = exp_sum16(p, mx);
        lsum = lsum * alpha + rs;
        const bf16x8 pf0 = pack8(p[0], p[1], p[2], p[3], p[4], p[5], p[6], p[7]), pf1 = pack8(p[8], p[9], p[10], p[11], p[12], p[13], p[14], p[15]);
        if (__builtin_amdgcn_ballot_w64(alpha != 1.f) != 0ull) { scale16(o0, alpha); scale16(o1, alpha); }
        const unsigned char* vb = st + trb;
#pragma unroll
        for (int ks = 0; ks < 2; ++ks) {
            const bf16x8 pf = ks == 0 ? pf0 : pf1;
            const s16x4 a0l = vtr(vb + ks * 16 * DA_VROW), a0h = vtr(vb + (ks * 16 + 8) * DA_VROW);
            const s16x4 a1l = vtr(vb + ks * 16 * DA_VROW + 64), a1h = vtr(vb + (ks * 16 + 8) * DA_VROW + 64);
            const bf16x8 va0 = __builtin_shufflevector(a0l, a0h, 0, 1, 2, 3, 4, 5, 6, 7), va1 = __builtin_shufflevector(a1l, a1h, 0, 1, 2, 3, 4, 5, 6, 7);
            o0 = MFMA32(va0, pf, o0); o1 = MFMA32(va1, pf, o1);
        }
    }
#undef DSW_LOAD
#undef DSW_STAGE
#undef DSW_ROW
    lsum += __shfl_xor(lsum, 32);
}

DI void dsw_unit(unsigned char* lds, int bl, int sb, int h, const bf16_t* proj, size_t mats, bf16_t* AO) {
    const int tid = mk_tid(), lane = tid & 63, wid = __builtin_amdgcn_readfirstlane(tid >> 6), r32 = lane & 31, hi = lane >> 5;
    const size_t rowbase = (size_t)bl * SEQ; const int T0s = sb * 512;
    unsigned char* st = lds + DA_VST + wid * DA_VBYTES;
    const int lrow = lane >> 3, lch = lane & 7;
    const int trb = ((lane >> 4) & 1) * 32 + (lane & 3) * 8 + (4 * hi + ((lane & 15) >> 2)) * DA_VROW;
    const unsigned char* kfb = st + r32 * DA_VROW + 16 * hi;
    f32x16 o0, o1; float mrow, lsum;
#pragma unroll 1
    for (int qt = 0; qt < 2; ++qt) {
        const int cls = 2 * wid + qt, e0w = T0s >> 4, tq = T0s + 16 * r32 + cls;
        int jmin = 4 - (e0w >> 5); jmin = jmin < 0 ? 0 : jmin;
        const size_t hb = rowbase * DM + h * HD;
        dsw_group(proj + 2 * mats + hb, proj + 5 * mats + hb, proj + 8 * mats + hb, 16, cls, e0w, tq, jmin, st, kfb, trb, lrow, lch, r32, hi, o0, o1, mrow, lsum);
        const float inv = 1.f / lsum;
        bf16_t* orow = AO + (rowbase + tq) * DM + h * HD + 4 * hi;
#pragma unroll
        for (int mt = 0; mt < 2; ++mt)
#pragma unroll
            for (int q = 0; q < 4; ++q) { const f32x16& o = mt ? o1 : o0;
                u32x2 w; w.x = cvtpk(o[4 * q] * inv, o[4 * q + 1] * inv); w.y = cvtpk(o[4 * q + 2] * inv, o[4 * q + 3] * inv);
                *(u32x2*)(orow + 32 * mt + 8 * q) = w; }
        if (hi == 0) ((float*)(lds + DA_LSE2))[tq - T0s] = mrow + __log2f(lsum);
    }
    __syncthreads();
#pragma unroll 1
    for (int half = 0; half < 2; ++half) {
        const int T0 = T0s + 256 * half;
        const size_t coff = (rowbase + T0 + (tid >> 1)) * DM + h * HD + 32 * (tid & 1);
        u32x4 gt4[4];
#pragma unroll
        for (int c = 0; c < 4; ++c) gt4[c] = *(const u32x4*)(proj + 9 * mats + coff + 8 * c);
#pragma unroll 1
        for (int g = 0; g < 2; ++g) {
            const size_t hb = rowbase * DM + h * HD;
            int e0w, cls, tq, R;
            if (g == 0) { R = 1; cls = 0;       e0w = T0 + 32 * wid;                 tq = e0w + r32; }
            else        { R = 4; cls = wid & 3; e0w = (T0 >> 2) + 32 * (wid >> 2);   tq = 4 * (e0w + r32) + cls; }
            int jmin = 4 - (e0w >> 5); jmin = jmin < 0 ? 0 : jmin;
            dsw_group(proj + (size_t)g * mats + hb, proj + (size_t)(3 + g) * mats + hb, proj + (size_t)(6 + g) * mats + hb, R, cls, e0w, tq, jmin, st, kfb, trb, lrow, lch, r32, hi, o0, o1, mrow, lsum);
            const float inv = 1.f / lsum;
            const int tl = tq - T0;
            unsigned char* og = lds + DA_OG + g * 32768 + tl * 128 + 8 * hi;
#pragma unroll
            for (int mt = 0; mt < 2; ++mt)
#pragma unroll
                for (int q = 0; q < 4; ++q) { const f32x16& o = mt ? o1 : o0;
                    u32x2 w; w.x = cvtpk(o[4 * q] * inv, o[4 * q + 1] * inv); w.y = cvtpk(o[4 * q + 2] * inv, o[4 * q + 3] * inv);
                    *(u32x2*)(og + 64 * mt + 16 * q) = w; }
            if (hi == 0) ((float*)(lds + DA_LSE))[g * 256 + tl] = mrow + __log2f(lsum);
        }
        __syncthreads();
        {
            const int tl = tid >> 1, dh = tid & 1;
            const float* lse = (const float*)(lds + DA_LSE);
            const float l0 = lse[tl], l1 = lse[256 + tl], l2 = ((const float*)(lds + DA_LSE2))[256 * half + tl], mx = fmaxf(l0, fmaxf(l1, l2));
            float w0 = fexp2(l0 - mx), w1 = fexp2(l1 - mx), w2 = fexp2(l2 - mx); const float inv = 1.f / (w0 + w1 + w2); w0 *= inv; w1 *= inv; w2 *= inv;
#pragma unroll
            for (int c = 0; c < 4; ++c) {
                const u32x4 a = *(const u32x4*)(lds + DA_OG + tl * 128 + 64 * dh + 16 * c), bq = *(const u32x4*)(lds + DA_OG + 32768 + tl * 128 + 64 * dh + 16 * c),
                            cq = *(const u32x4*)(AO + coff + 8 * c), gt = gt4[c];
                u32x4 w;
#pragma unroll
                for (int e = 0; e < 4; ++e) {
                    const float lo = (w0 * bf_lo(a[e]) + w1 * bf_lo(bq[e]) + w2 * bf_lo(cq[e])) * silu(bf_lo(gt[e]));
                    const float hv = (w0 * bf_hi(a[e]) + w1 * bf_hi(bq[e]) + w2 * bf_hi(cq[e])) * silu(bf_hi(gt[e]));
                    w[e] = cvtpk(lo, hv);
                }
                *(u32x4*)(AO + coff + 8 * c) = w;
            }
        }
        __syncthreads();
    }
}
DI void dsw_attn_phase(unsigned char* lds, const bf16_t* proj, bf16_t* AO_half) {
    const size_t mats = (size_t)(MTOK / 2) * DM;
    for (int u = blockIdx.x; u < 256; u += gridDim.x) dsw_unit(lds, u >> 6, (u >> 4) & 3, u & 15, proj, mats, AO_half);
}

typedef __attribute__((address_space(1))) unsigned gu32;
#define XB_TMO      128
#define XB_XCNT(j)  (256  + 64 * (j))
#define XB_XSUB(j)  (1280 + 64 * (j))
#define XB_XGEN(j)  (2304 + 64 * (j))
#define XB_TOP      3328
#define XB_TOPGEN   3392
#define XCD_BAR_WORDS 3456
#define XB_SPIN_CAP (1u << 18)

__device__ __forceinline__ unsigned xb_ld(unsigned* p)              { return __hip_atomic_load(p, __ATOMIC_RELAXED, __HIP_MEMORY_SCOPE_AGENT); }
__device__ __forceinline__ unsigned xb_add(unsigned* p, unsigned v) { return __hip_atomic_fetch_add(p, v, __ATOMIC_RELAXED, __HIP_MEMORY_SCOPE_AGENT); }
__device__ __forceinline__ unsigned xb_xcc_id() { return (unsigned)__builtin_amdgcn_s_getreg((3 << 11) | 20) & 0xFu; }
#define XB_SPIN(cond, bar) do { unsigned _sp = 0; while (cond) { __builtin_amdgcn_s_sleep(1); \
    if ((++_sp & 255u) == 0u) { if (xb_ld(&(bar)[XB_TMO])) break; if (_sp > XB_SPIN_CAP) { atomicAdd(&(bar)[XB_TMO], 1u); break; } } } } while (0)

struct XcdBarrier {
    unsigned* bar; unsigned x;
    volatile LAS unsigned* st;
};

__device__ __forceinline__ XcdBarrier xcd_barrier_post(unsigned* bar, volatile LAS unsigned* st) {
    XcdBarrier b; b.bar = bar; b.x = xb_xcc_id(); b.st = st;
    if (threadIdx.x == 0) (void)xb_add(&bar[XB_XCNT(b.x)], 1u);
    return b;
}
__device__ __forceinline__ void xcd_barrier_complete(unsigned* bar, unsigned x, unsigned& nloc, unsigned& nx) {
    const unsigned G = gridDim.x * gridDim.y * gridDim.z;
    unsigned sum, cnt, mine, sp = 0u;
    for (;;) {
        sum = 0u; cnt = 0u; mine = 0u;
#pragma unroll
        for (unsigned j = 0; j < 16; ++j) { const unsigned c = xb_ld(&bar[XB_XCNT(j)]); sum += c; cnt += (c > 0u) ? 1u : 0u; mine = (j == x) ? c : mine; }
        if (sum == G) break;
        __builtin_amdgcn_s_sleep(1);
        if ((++sp & 255u) == 0u) { if (xb_ld(&bar[XB_TMO])) break; if (sp > XB_SPIN_CAP) { atomicAdd(&bar[XB_TMO], 1u); break; } }
    }
    nloc = mine > 0u ? mine : 1u; nx = cnt > 0u ? cnt : 1u;
}

__device__ __forceinline__ void xcd_barrier(const XcdBarrier& b) {
    asm volatile("s_waitcnt vmcnt(0)" ::: "memory");
    __syncthreads();
    if (threadIdx.x == 0) {
        unsigned* bar = b.bar;
        __builtin_amdgcn_s_waitcnt(0);
        unsigned nloc = b.st[0], nx = b.st[1];
        if (nloc == 0u) { xcd_barrier_complete(bar, b.x, nloc, nx); b.st[0] = nloc; b.st[1] = nx; }
        const unsigned old = xb_add(&bar[XB_XSUB(b.x)], 1u);
        const unsigned gen = old / nloc;
        if (old + 1u == (gen + 1u) * nloc) {
            __builtin_amdgcn_fence(__ATOMIC_RELEASE, "agent");
            asm volatile("s_waitcnt vmcnt(0)" ::: "memory");
            const unsigned og = xb_add(&bar[XB_TOP], 1u);
            const unsigned tg = og / nx;
            if (og + 1u == (tg + 1u) * nx) xb_add(&bar[XB_TOPGEN], 1u);
            else XB_SPIN(xb_ld(&bar[XB_TOPGEN]) == tg, bar);
            __builtin_amdgcn_fence(__ATOMIC_ACQUIRE, "agent");
            xb_add(&bar[XB_XGEN(b.x)], 1u);
            asm volatile("s_waitcnt vmcnt(0)" ::: "memory");
        } else {
            XB_SPIN(xb_ld(&bar[XB_XGEN(b.x)]) == gen, bar);
            __builtin_amdgcn_fence(__ATOMIC_ACQUIRE, "agent");
            asm volatile("s_waitcnt vmcnt(0)" ::: "memory");
        }
    }
    __syncthreads();
}

__global__ void __launch_bounds__(NTHREADS, 2) fwd_megakernel(Args a) {
    extern __shared__ __attribute__((aligned(16))) unsigned char lds[];
    cg::grid_group grid = cg::this_grid();
    unsigned char* ws = a.ws;
    bf16_t* XB = (bf16_t*)(ws + WS_XB); bf16_t* AO = (bf16_t*)(ws + WS_AO); bf16_t* PROJ = (bf16_t*)(ws + WS_PROJ);
    float* SSQ = (float*)(ws + WS_SSQ); float* ROT = (float*)(ws + WS_ROT); float* CLOC = (float*)(ws + WS_CLOC); float* CTOT = (float*)(ws + WS_CTOT);
    PG8_LAS unsigned char* ldsl = (PG8_LAS unsigned char*)lds;

    volatile LAS unsigned* MISC = (volatile LAS unsigned*)((LAS unsigned char*)lds + LDS_BYTES - 64);
    if (threadIdx.x < 16) MISC[threadIdx.x] = 0u;
    __syncthreads();
    for (int rep = 0; rep < REP_PRO; ++rep) prologue(a, lds);
    if (blockIdx.x == 0) for (int w = threadIdx.x; w < (int)(CTL_ZERO_BYTES / 4); w += NTHREADS) __hip_atomic_store((unsigned*)(ws + WS_CTL) + w, 0u, __ATOMIC_RELAXED, __HIP_MEMORY_SCOPE_AGENT);
    grid.sync();
    XcdBarrier bar = xcd_barrier_post((unsigned*)(ws + WS_CTL), MISC);
#pragma unroll 1
    for (int layer = 0; layer < 4; ++layer) {
        const int j = layer >> 1; const bool dsw = layer & 1;
        const float* xcur = layer == 0 ? a.x : a.out;
        const int nhalf = dsw ? 2 : 1;
#pragma unroll 1
        for (int half = 0; half < nhalf; ++half) {
            if (!dsw) for (int rep = 0; rep < REP_FG; ++rep) fg_step(xcur, (const bf16_t*)(ws + WS_WF) + (size_t)j * 2 * 16 * DM, a.fox_b_f + j * NH, CLOC, CTOT, lds);
            for (int rep = 0; rep < REP_PROJ; ++rep) {
                const int Mg = dsw ? MTOK / 2 : MTOK, Ng = dsw ? 10240 : 4096, row_off = half * (MTOK / 2);
                const bf16_t* Bt = dsw ? (const bf16_t*)(ws + WS_WDSW) + (size_t)j * 10240 * DM : (const bf16_t*)(ws + WS_WFOX) + (size_t)j * 4096 * DM;
                pg8::Gemm g{XB + (size_t)row_off * DM, Bt, Mg, Ng, DM}; pg8::StaticOrder S; S.init(Mg, Ng, (int)gridDim.x, (int)blockIdx.x);
                EpiProj E{PROJ, (size_t)Mg * DM, SSQ, ROT, row_off, dsw ? a.dsw_qn + j * 3 * HD : a.fox_qn + j * HD, dsw ? a.dsw_kn + j * 3 * HD : a.fox_kn + j * HD, dsw ? 3 : 1};
                pg8::gemm_phase<EpiProj, pg8::StaticOrder, true, true>(ldsl, g, S, E);
            }
            xcd_barrier(bar);
            if (!dsw) for (int rep = 0; rep < REP_FOX; ++rep) fox_attn_phase(lds, PROJ, AO, CLOC, CTOT, a.fox_qn + j * HD, a.fox_kn + j * HD, (unsigned*)(ws + WS_CTL) + 3600 + j);
            if (dsw) for (int rep = 0; rep < REP_DSW; ++rep) dsw_attn_phase(lds, PROJ, AO + (size_t)half * (MTOK / 2) * DM);
            xcd_barrier(bar);
        }
        {
            pg8::Gemm g{AO, (const bf16_t*)(ws + WS_WOUT) + (size_t)layer * DM * DM, MTOK, DM, DM}; pg8::StaticOrder S; S.init(MTOK, DM, (int)gridDim.x, (int)blockIdx.x);
            EpiOut E{xcur, a.out, XB, SSQ, layer == 3 ? 1 : 0};
            pg8::gemm_phase<EpiOut, pg8::StaticOrder, true, true>(ldsl, g, S, E);
        }
        if (layer < 3) for (int rep = 0; rep < REP_SYNC; ++rep) xcd_barrier(bar);
    }
}

extern "C" void kernel_launch(void* const* d_in, const int* in_sizes, int n_in, void* d_out, int out_size, void* d_ws, size_t ws_size, hipStream_t stream) {
    static int grid_blocks = 0;
    if (grid_blocks == 0) {
        if (n_in != 12 || in_sizes[0] != MTOK * DM || out_size != MTOK * DM || ws_size < WS_END) {
            fprintf(stderr, "kernel_launch: unexpected shapes (n_in %d, in0 %d, out %d, ws %zu < %zu); nothing launched\n", n_in, n_in > 0 ? in_sizes[0] : -1, out_size, ws_size, (size_t)WS_END); grid_blocks = -1; return; }
        int dev = 0, cus = 0, per_cu = 0;
        hipGetDevice(&dev); hipDeviceGetAttribute(&cus, hipDeviceAttributeMultiprocessorCount, dev);
        if (hipFuncSetAttribute((const void*)fwd_megakernel, hipFuncAttributeMaxDynamicSharedMemorySize, LDS_BYTES) != hipSuccess) { fprintf(stderr, "kernel_launch: hipFuncSetAttribute failed\n"); grid_blocks = -1; return; }
        if (hipOccupancyMaxActiveBlocksPerMultiprocessor(&per_cu, (const void*)fwd_megakernel, NTHREADS, LDS_BYTES) != hipSuccess || per_cu < 1) { fprintf(stderr, "kernel_launch: occupancy query failed (%d)\n", per_cu); grid_blocks = -1; return; }
        grid_blocks = cus * per_cu;
    }
    if (grid_blocks < 0) return;
    Args a{};
    a.x = (const float*)d_in[0]; a.pos = (const int*)d_in[1]; a.norm_g = (const float*)d_in[2]; a.fox_w_in = (const float*)d_in[3]; a.fox_b_f = (const float*)d_in[4];
    a.fox_qn = (const float*)d_in[5]; a.fox_kn = (const float*)d_in[6]; a.fox_w_out = (const float*)d_in[7]; a.dsw_w_in = (const float*)d_in[8]; a.dsw_qn = (const float*)d_in[9];
    a.dsw_kn = (const float*)d_in[10]; a.dsw_w_out = (const float*)d_in[11]; a.out = (float*)d_out; a.ws = (unsigned char*)d_ws;
    void* args[] = {&a};
    hipError_t e = hipLaunchCooperativeKernel((const void*)fwd_megakernel, dim3(grid_blocks), dim3(NTHREADS), args, LDS_BYTES, stream);
    if (e != hipSuccess) fprintf(stderr, "kernel_launch: cooperative launch failed: %s (grid %d)\n", hipGetErrorString(e), grid_blocks);
}
```

```cpp
#include <hip/hip_runtime.h>
#include <hip/hip_cooperative_groups.h>
#include <cstdio>
#include <cstdint>
namespace cg = cooperative_groups;
#define REP_PRO 1
#define REP_FG 1
#define REP_PROJ 1
#define REP_FOX 1
#define REP_DSW 1
#define REP_SYNC 1
__device__ __forceinline__ int mk_tid() { int t = threadIdx.x; asm volatile("" : "+v"(t)); return t; }
namespace pg8 {
#define PG8_LAS __attribute__((address_space(3)))
typedef unsigned short bf16_t;
typedef short bf16x8 __attribute__((ext_vector_type(8)));
typedef float f32x4 __attribute__((ext_vector_type(4)));
typedef unsigned u32x4 __attribute__((ext_vector_type(4)));
constexpr int BM = 256, BK = 64, HALF = 128, HTB = HALF * BK * 2  , STAGE_BYTES = 8 * HTB, NXCD = 8, WGM = 8;

__host__ __device__ __forceinline__ int lds_byte(int r, int c) { const int st = (r >> 4) * 2 + (c >> 5), rr = r & 15, cc = c & 31, ob = rr * 64 + cc * 2; return st * 1024 + (ob ^ (((ob >> 9) & 1) << 5)); }
__host__ __device__ __forceinline__ void stage_rc(int b, int& R, int& C) { const int st = b / 1024, sb = b % 1024, swz = sb ^ (((sb >> 9) & 1) << 5); R = (st >> 1) * 16 + swz / 64; C = (st & 1) * 32 + (swz % 64) / 2; }
__host__ __device__ __forceinline__ int perm32(int rho) { const int n = rho >> 4, i = rho & 15; return 8 * (i >> 2) + 4 * n + (i & 3); }

struct Unit { int pm, pn; };
struct Gemm { const bf16_t* A; const bf16_t* Bt; int M, N, K; };

struct StaticOrder {
    int nM, nN, nwg, G, c;
    __host__ __device__ void init(int M, int N, int G_, int c_) { nM = M / BM; nN = N / BM; nwg = nM * nN; G = G_; c = c_; }
    __host__ __device__ bool next(int i, Unit& u) const {
        const long L = (long)i * G + c; if (L >= nwg) return false;
        int wgid = (int)L; { const int q = nwg / NXCD, r = nwg % NXCD, xcd = wgid % NXCD, off = wgid / NXCD; wgid = (xcd < r ? xcd * (q + 1) : r * (q + 1) + (xcd - r) * q) + off; }
        const int nig = WGM * nN, gid = wgid / nig, fm = gid * WGM, gsz = (nM - fm) < WGM ? (nM - fm) : WGM;
        u.pm = fm + ((wgid % nig) % gsz); u.pn = (wgid % nig) / gsz; return true;
    }
    __device__ __forceinline__ void a_ready(const Unit&) const {}
    __device__ __forceinline__ void done(const Unit&) const {}
};

__device__ __forceinline__ unsigned cvt_pk_bf16(float lo, float hi) { unsigned r; asm volatile("v_cvt_pk_bf16_f32 %0, %1, %2" : "=v"(r) : "v"(lo), "v"(hi)); return r; }
template <class Epi, class Sched, bool ALIGN_EPI = false, bool SP2 = false>
__device__ __forceinline__ void gemm_phase(PG8_LAS unsigned char* lds, const Gemm g, const Sched& S, const Epi& E) {
    const int tid = mk_tid(), wid = __builtin_amdgcn_readfirstlane(tid >> 6), lane = tid & 63, wr = wid >> 2, wc = wid & 3, fr = lane & 15, fq = lane >> 4;
    const int K = g.K, nt = K / BK;
    unsigned voffA[2], voffB[2];
#pragma unroll
    for (int i = 0; i < 2; ++i) { int R, C; stage_rc(tid * 16 + i * 8192, R, C); const int Rb = Epi::PERM ? ((R & ~31) + perm32(R & 31)) : R;
        voffA[i] = (unsigned)(R * K + C) * 2u; voffB[i] = (unsigned)(Rb * K + C) * 2u; }
    const size_t kstep = (size_t)(BK * 2);
    const size_t hstep = (size_t)HALF * K * 2;
    const size_t tstep = 2 * hstep;
    const unsigned ldsw = (unsigned)wid * 1024u;
    const int aoff = lds_byte(wr * 64 + fr, fq * 8), boff = lds_byte(wc * 32 + fr, fq * 8);
#define PG8_SA(b, h) (((b) * 2 + (h)) * HTB)
#define PG8_SB(b, h) ((4 + (b) * 2 + (h)) * HTB)
#define PG8_STAGE(bufoff, gbase, voff) do { _Pragma("unroll") for (int _i = 0; _i < 2; ++_i) \
        __builtin_amdgcn_global_load_lds((const unsigned*)((const char*)(gbase) + (voff)[_i]), (PG8_LAS unsigned*)(lds + (bufoff) + ldsw + _i * 8192), 16, 0, 0); } while (0)
#define PG8_LDA(dst, b, h) do { _Pragma("unroll") for (int m = 0; m < 4; ++m) _Pragma("unroll") for (int k = 0; k < 2; ++k) dst[m][k] = *(const PG8_LAS bf16x8*)(lds + PG8_SA(b, h) + aoff + m * 2048 + k * 1024); } while (0)
#define PG8_LDB(dst, b, h) do { _Pragma("unroll") for (int n = 0; n < 2; ++n) _Pragma("unroll") for (int k = 0; k < 2; ++k) dst[n][k] = *(const PG8_LAS bf16x8*)(lds + PG8_SB(b, h) + boff + n * 2048 + k * 1024); } while (0)
#define PG8_MMA(ai, bj, At, Bt) do { __builtin_amdgcn_s_setprio(1); _Pragma("unroll") for (int m = 0; m < 4; ++m) _Pragma("unroll") for (int n = 0; n < 2; ++n) _Pragma("unroll") for (int k = 0; k < 2; ++k) \
        acc[ai][bj][m][n] = __builtin_amdgcn_mfma_f32_16x16x32_bf16(Bt[n][k], At[m][k], acc[ai][bj][m][n], 0, 0, 0); __builtin_amdgcn_s_setprio(0); } while (0)
#define PG8_WAIT_V(n) asm volatile("s_waitcnt vmcnt(" #n ")" ::: "memory")
#define PG8_WAIT_L(n) asm volatile("s_waitcnt lgkmcnt(" #n ")" ::: "memory")
#define PG8_BAR __builtin_amdgcn_s_barrier()
#define PG8_SCHED __builtin_amdgcn_sched_barrier(0)
    Unit cur, nxt; int ui = 0;
    if (!S.next(0, cur)) return;
    f32x4 acc[2][2][4][2];
#pragma unroll
    for (int a = 0; a < 2; ++a)
#pragma unroll
        for (int b = 0; b < 2; ++b)
#pragma unroll
            for (int m = 0; m < 4; ++m)
#pragma unroll
                for (int n = 0; n < 2; ++n) acc[a][b][m][n] = (f32x4){0.f, 0.f, 0.f, 0.f};
    bf16x8 At[4][2], B0[2][2], B1[2][2];
    const char* cA = (const char*)g.A + (size_t)cur.pm * tstep; const char* cB = (const char*)g.Bt + (size_t)cur.pn * tstep;
    S.a_ready(cur);
    if constexpr (SP2) {
        PG8_STAGE(PG8_SB(0, 0), cB, voffB); PG8_STAGE(PG8_SB(0, 1), cB + hstep, voffB); PG8_STAGE(PG8_SA(0, 0), cA, voffA); PG8_STAGE(PG8_SA(0, 1), cA + hstep, voffA);
        if (wr == 1) PG8_BAR;
        PG8_WAIT_V(2); PG8_BAR;
        PG8_STAGE(PG8_SB(1, 0), cB + kstep, voffB); PG8_STAGE(PG8_SA(1, 0), cA + kstep, voffA); PG8_STAGE(PG8_SB(1, 1), cB + hstep + kstep, voffB);
        PG8_WAIT_V(6); PG8_BAR;
    } else {
        PG8_STAGE(PG8_SB(0, 0), cB, voffB); PG8_STAGE(PG8_SA(0, 0), cA, voffA); PG8_STAGE(PG8_SB(0, 1), cB + hstep, voffB); PG8_STAGE(PG8_SA(0, 1), cA + hstep, voffA);
        if (wr == 1) PG8_BAR;
        PG8_WAIT_V(4); PG8_BAR;
        PG8_STAGE(PG8_SB(1, 0), cB + kstep, voffB); PG8_STAGE(PG8_SA(1, 0), cA + kstep, voffA); PG8_STAGE(PG8_SB(1, 1), cB + hstep + kstep, voffB);
        PG8_WAIT_V(6); PG8_BAR;
    }
    for (;;) {
        const bool has_next = S.next(ui + 1, nxt);
        const char* nA = has_next ? (const char*)g.A + (size_t)nxt.pm * tstep : cA; const char* nB = has_next ? (const char*)g.Bt + (size_t)nxt.pn * tstep : cB;
        for (int t = 0; t < nt; t += 2) {
            const bool last = (t == nt - 2);
            const char* a1 = cA + (size_t)(t + 1) * kstep;
            const char* a2 = last ? nA : cA + (size_t)(t + 2) * kstep; const char* b2 = last ? nB : cB + (size_t)(t + 2) * kstep;
            const char* a3 = a2 + kstep; const char* b3 = b2 + kstep;
            if (last && has_next) S.a_ready(nxt);
            if constexpr (SP2) {
            PG8_LDB(B0, 0, 0); PG8_LDB(B1, 0, 1); PG8_SCHED; PG8_LDA(At, 0, 0); PG8_STAGE(PG8_SA(1, 1), a1 + hstep, voffA);
            PG8_WAIT_V(8); PG8_WAIT_L(0); PG8_BAR; PG8_MMA(0, 0, At, B0); PG8_MMA(0, 1, At, B1); PG8_BAR; PG8_SCHED;
            PG8_LDA(At, 0, 1); PG8_STAGE(PG8_SB(0, 0), b2, voffB); PG8_STAGE(PG8_SB(0, 1), b2 + hstep, voffB); PG8_STAGE(PG8_SA(0, 0), a2, voffA);
            PG8_WAIT_V(8); PG8_WAIT_L(0); PG8_BAR; PG8_MMA(1, 0, At, B0); PG8_MMA(1, 1, At, B1); PG8_BAR; PG8_SCHED;
            PG8_LDB(B0, 1, 0); PG8_LDB(B1, 1, 1); PG8_SCHED; PG8_LDA(At, 1, 0); PG8_STAGE(PG8_SA(0, 1), a2 + hstep, voffA);
            PG8_WAIT_V(8); PG8_WAIT_L(0); PG8_BAR; PG8_MMA(0, 0, At, B0); PG8_MMA(0, 1, At, B1); PG8_BAR; PG8_SCHED;
            PG8_LDA(At, 1, 1); PG8_STAGE(PG8_SB(1, 0), b3, voffB); PG8_STAGE(PG8_SB(1, 1), b3 + hstep, voffB); PG8_STAGE(PG8_SA(1, 0), a3, voffA);
            PG8_WAIT_V(8); PG8_WAIT_L(0); PG8_BAR; PG8_MMA(1, 0, At, B0); PG8_MMA(1, 1, At, B1); PG8_BAR; PG8_SCHED;
            } else {
            PG8_LDB(B0, 0, 0); PG8_SCHED; PG8_LDA(At, 0, 0); PG8_STAGE(PG8_SA(1, 1), a1 + hstep, voffA);
            PG8_WAIT_L(8); PG8_BAR; PG8_WAIT_L(0); PG8_MMA(0, 0, At, B0); PG8_BAR; PG8_SCHED;
            PG8_LDB(B1, 0, 1); PG8_STAGE(PG8_SB(0, 0), b2, voffB);
            PG8_BAR; PG8_WAIT_L(0); PG8_MMA(0, 1, At, B1); PG8_BAR;
            PG8_LDA(At, 0, 1); PG8_STAGE(PG8_SA(0, 0), a2, voffA);
            PG8_BAR; PG8_WAIT_L(0); PG8_MMA(1, 0, At, B0); PG8_BAR; PG8_SCHED;
            PG8_STAGE(PG8_SB(0, 1), b2 + hstep, voffB);
            PG8_WAIT_V(6); PG8_BAR; PG8_MMA(1, 1, At, B1); PG8_BAR;
            PG8_LDB(B0, 1, 0); PG8_SCHED; PG8_LDA(At, 1, 0); PG8_STAGE(PG8_SA(0, 1), a2 + hstep, voffA);
            PG8_WAIT_L(8); PG8_BAR; PG8_WAIT_L(0); PG8_MMA(0, 0, At, B0); PG8_BAR; PG8_SCHED;
            PG8_LDB(B1, 1, 1); PG8_STAGE(PG8_SB(1, 0), b3, voffB);
            PG8_BAR; PG8_WAIT_L(0); PG8_MMA(0, 1, At, B1); PG8_BAR;
            PG8_LDA(At, 1, 1); PG8_STAGE(PG8_SA(1, 0), a3, voffA);
            PG8_BAR; PG8_WAIT_L(0); PG8_MMA(1, 0, At, B0); PG8_BAR; PG8_SCHED;
            PG8_STAGE(PG8_SB(1, 1), b3 + hstep, voffB);
            PG8_WAIT_V(6); PG8_BAR; PG8_MMA(1, 1, At, B1); PG8_BAR;
            }
        }
        if constexpr (ALIGN_EPI) { if (wr == 0) PG8_BAR; }
        if constexpr (!Epi::AFTER_DRAIN) { E(acc, cur, wr, wc, fr, fq); S.done(cur); }
        if (!has_next) break;
#pragma unroll
        for (int a = 0; a < 2; ++a)
#pragma unroll
            for (int b = 0; b < 2; ++b)
#pragma unroll
                for (int m = 0; m < 4; ++m)
#pragma unroll
                    for (int n = 0; n < 2; ++n) acc[a][b][m][n] = (f32x4){0.f, 0.f, 0.f, 0.f};
        cur = nxt; cA = nA; cB = nB; ++ui;
        if constexpr (ALIGN_EPI) { if (wr == 1) PG8_BAR; }
    }
    PG8_WAIT_V(0);
    if constexpr (!ALIGN_EPI) { if (wr == 0) PG8_BAR; }
    PG8_BAR;
    if constexpr (Epi::AFTER_DRAIN) { E.fused(acc, cur, wr, wc, fr, fq, lds, wid, lane); S.done(cur); }
#undef PG8_SA
#undef PG8_SB
#undef PG8_STAGE
#undef PG8_LDA
#undef PG8_LDB
#undef PG8_MMA
#undef PG8_WAIT_V
#undef PG8_WAIT_L
#undef PG8_BAR
#undef PG8_SCHED
}
}

#define DI __device__ __forceinline__
#define LAS __attribute__((address_space(3)))
typedef unsigned short bf16_t;
typedef short bf16x8 __attribute__((ext_vector_type(8)));
typedef short s16x4 __attribute__((ext_vector_type(4)));
typedef float f32x4 __attribute__((ext_vector_type(4)));
typedef float f32x16 __attribute__((ext_vector_type(16)));
typedef unsigned u32x4 __attribute__((ext_vector_type(4)));
typedef unsigned u32x2 __attribute__((ext_vector_type(2)));
typedef float f32x2_t __attribute__((ext_vector_type(2)));
typedef __bf16 bf16x2_t __attribute__((ext_vector_type(2)));
typedef short v4i16_t __attribute__((ext_vector_type(4)));

constexpr int NTHREADS = 512, NWAVES = 8;
constexpr int BATCH = 8, SEQ = 2048, DM = 1024, NH = 16, HD = 64, MTOK = BATCH * SEQ;
constexpr int FOX_IN = 4 * DM + NH, DSW_IN = 10 * DM;
constexpr float EPS = 1e-6f;
constexpr float LOG2E = 1.4426950408889634f;
constexpr float C2 = 0.125f * LOG2E;
constexpr int LDS_BYTES = 147456;

constexpr size_t MiB = 1u << 20;
constexpr size_t WS_CTL = 0, CTL_ZERO_BYTES = 16384;
constexpr size_t WS_ROT = 1 * MiB;
constexpr size_t WS_SSQ = 2 * MiB;
constexpr size_t WS_CLOC = 3 * MiB;
constexpr size_t WS_CTOT = 4 * MiB;
constexpr size_t WS_WF = 5 * MiB;
constexpr size_t WS_WFOX = 8 * MiB;
constexpr size_t WS_WDSW = 24 * MiB;
constexpr size_t WS_WOUT = 64 * MiB;
constexpr size_t WS_XB = 72 * MiB;
constexpr size_t WS_AO = 104 * MiB;
constexpr size_t WS_PROJ = 136 * MiB;
constexpr size_t WS_END = 296 * MiB;

DI unsigned cvtpk(float lo, float hi) { f32x2_t v = {lo, hi}; bf16x2_t b = __builtin_convertvector(v, bf16x2_t); return __builtin_bit_cast(unsigned, b); }
DI float bf_lo(unsigned w) { return __uint_as_float(w << 16); }
DI float bf_hi(unsigned w) { return __uint_as_float(w & 0xffff0000u); }
DI float fexp2(float x) { return __builtin_amdgcn_exp2f(x); }
DI float silu(float g) { return g / (1.f + __expf(-g)); }
DI s16x4 vtr(const void* p) { return __builtin_bit_cast(s16x4, __builtin_amdgcn_ds_read_tr16_b64_v4i16((LAS v4i16_t*)p)); }
DI int crow(int i, int hi) { return (i & 3) + 8 * (i >> 2) + 4 * hi; }
#define MFMA32(a, b, c) __builtin_amdgcn_mfma_f32_32x32x16_bf16((a), (b), (c), 0, 0, 0)
DI bf16x8 pack8(float a0, float a1, float a2, float a3, float a4, float a5, float a6, float a7) {
    u32x4 w; w.x = cvtpk(a0, a1); w.y = cvtpk(a2, a3); w.z = cvtpk(a4, a5); w.w = cvtpk(a6, a7); return __builtin_bit_cast(bf16x8, w);
}

struct EpiProj {
    static constexpr bool PERM = true, AFTER_DRAIN = false;
    bf16_t* out; size_t mats;
    const float* ssq; const float* rot; int row_off;
    const float* qg; const float* kg; int nq;
    DI void operator()(const f32x4 (&acc)[2][2][4][2], const pg8::Unit& u, int wr, int wc, int fr, int fq) const {
        const int mat = u.pn >> 2, head = (u.pn & 3) * 4 + wc;
        const int kind = mat < nq ? 1 : (mat < 2 * nq ? 2 : 0);
        const float* gp = kind == 1 ? qg + 64 * mat : kg + 64 * (mat - nq);
        f32x4 gn[2][2];
#pragma unroll
        for (int bj = 0; bj < 2; ++bj)
#pragma unroll
            for (int n = 0; n < 2; ++n) gn[bj][n] = kind ? *(const f32x4*)(gp + 32 * bj + 8 * fq + 4 * n) : (f32x4){1.f, 1.f, 1.f, 1.f};
        const float qs = kind == 1 ? C2 : 1.f;
        bf16_t* obase = out + (size_t)mat * mats + head * 64 + 8 * fq;
        const bool rotl = (nq == 3) && kind && fq < 2;
        float rstd[8];
#pragma unroll
        for (int hb = 0; hb < 2; ++hb) {
            f32x4 sp[4];
#pragma unroll
            for (int r = 0; r < 4; ++r) { const int row = u.pm * 256 + hb * 128 + wr * 64 + r * 16 + fr; sp[r] = *(const f32x4*)(ssq + (size_t)(row_off + row) * 16 + 4 * fq); }
#pragma unroll
            for (int r = 0; r < 4; ++r) { float t = (sp[r][0] + sp[r][1]) + (sp[r][2] + sp[r][3]); t += __shfl_xor(t, 16); t += __shfl_xor(t, 32); rstd[4 * hb + r] = rsqrtf(t * (1.f / DM) + EPS); }
        }
        f32x4 rc0 = {}, rc1 = {}, rs0 = {}, rs1 = {};
        if (rotl) { const float* rp = rot + (size_t)(row_off + u.pm * 256 + wr * 64 + fr) * 16; rc0 = *(const f32x4*)rp; rc1 = *(const f32x4*)(rp + 4); rs0 = *(const f32x4*)(rp + 8); rs1 = *(const f32x4*)(rp + 12); }
#pragma unroll
        for (int r = 0; r < 8; ++r) {
            const int ai = r >> 2, m = r & 3;
            const int row = u.pm * 256 + ai * 128 + wr * 64 + m * 16 + fr;
            const f32x4 c0 = rc0, c1 = rc1, s0 = rs0, s1 = rs1;
            if (rotl && r < 7) { const int rn = u.pm * 256 + ((r + 1) >> 2) * 128 + wr * 64 + ((r + 1) & 3) * 16 + fr; const float* rp = rot + (size_t)(row_off + rn) * 16;
                rc0 = *(const f32x4*)rp; rc1 = *(const f32x4*)(rp + 4); rs0 = *(const f32x4*)(rp + 8); rs1 = *(const f32x4*)(rp + 12); }
            f32x4 v[2][2];
#pragma unroll
            for (int bj = 0; bj < 2; ++bj)
#pragma unroll
                for (int n = 0; n < 2; ++n) v[bj][n] = acc[ai][bj][m][n] * rstd[r];
            if (kind) {
                float ss = 0.f;
#pragma unroll
                for (int bj = 0; bj < 2; ++bj)
#pragma unroll
                    for (int n = 0; n < 2; ++n) ss += (v[bj][n][0] * v[bj][n][0] + v[bj][n][1] * v[bj][n][1]) + (v[bj][n][2] * v[bj][n][2] + v[bj][n][3] * v[bj][n][3]);
                ss += __shfl_xor(ss, 16); ss += __shfl_xor(ss, 32);
                const float hr = rsqrtf(ss * (1.f / HD) + EPS) * qs;
#pragma unroll
                for (int bj = 0; bj < 2; ++bj)
#pragma unroll
                    for (int n = 0; n < 2; ++n) v[bj][n] = v[bj][n] * gn[bj][n] * hr;
                if (nq == 3) {
                    f32x4 o0, o1;
#pragma unroll
                    for (int e = 0; e < 4; ++e) { o0[e] = __shfl_xor(v[0][0][e], 16); o1[e] = __shfl_xor(v[0][1][e], 16); }
                    if (fq == 0) { v[0][0] = v[0][0] * c0 - o0 * s0; v[0][1] = v[0][1] * c1 - o1 * s1; }
                    else if (fq == 1) { v[0][0] = v[0][0] * c0 + o0 * s0; v[0][1] = v[0][1] * c1 + o1 * s1; }
                }
            }
            int prow = row;
            if (nq == 3 && mat < 9) { const int gi = mat % 3;
                if (gi == 1) prow = (row & ~511) + ((row & 3) << 7) + ((row & 511) >> 2);
                else if (gi == 2) prow = (row & ~511) + ((row & 15) << 5) + ((row & 511) >> 4); }
            bf16_t* rowp = obase + (size_t)prow * DM;
#pragma unroll
            for (int bj = 0; bj < 2; ++bj) {
                u32x4 w; w.x = cvtpk(v[bj][0][0], v[bj][0][1]); w.y = cvtpk(v[bj][0][2], v[bj][0][3]); w.z = cvtpk(v[bj][1][0], v[bj][1][1]); w.w = cvtpk(v[bj][1][2], v[bj][1][3]);
                *(u32x4*)(rowp + 32 * bj) = w;
            }
        }
    }
};

struct EpiOut {
    static constexpr bool PERM = false, AFTER_DRAIN = false;
    const float* xin; float* xout; bf16_t* xb; float* ssq; int last;
    DI void operator()(const f32x4 (&acc)[2][2][4][2], const pg8::Unit& u, int wr, int wc, int fr, int fq) const {
        const int col0 = u.pn * 256 + wc * 32 + 4 * fq;
#pragma unroll
        for (int ai = 0; ai < 2; ++ai)
#pragma unroll
            for (int m = 0; m < 4; ++m) {
                const size_t row = (size_t)(u.pm * 256 + ai * 128 + wr * 64 + m * 16 + fr);
                float ss = 0.f;
#pragma unroll
                for (int bj = 0; bj < 2; ++bj)
#pragma unroll
                    for (int n = 0; n < 2; ++n) {
                        const size_t off = row * DM + col0 + bj * 128 + n * 16;
                        const f32x4 xo = *(const f32x4*)(xin + off) + acc[ai][bj][m][n];
                        *(f32x4*)(xout + off) = xo;
                        if (!last) { u32x2 w; w.x = cvtpk(xo[0], xo[1]); w.y = cvtpk(xo[2], xo[3]); *(u32x2*)(xb + off) = w; }
                        ss += (xo[0] * xo[0] + xo[1] * xo[1]) + (xo[2] * xo[2] + xo[3] * xo[3]);
                    }
                ss += __shfl_xor(ss, 16); ss += __shfl_xor(ss, 32);
                if (fq == 0 && !last) ssq[row * 16 + u.pn * 4 + wc] = ss;
            }
    }
};

DI float wave_sum(float v) {
#pragma unroll
    for (int o = 1; o < 64; o <<= 1) v += __shfl_xor(v, o);
    return v;
}
DI void transpose_item(const float* W, int ldw, int N, bf16_t* WT, const float* gain, bool perm, float* scr, int item, int lane) {
    const int nblk = N / 32, kb = item / nblk, nb = item % nblk, k0 = 64 * kb, n0 = 32 * nb;
    const int c0 = perm ? ((n0 & ~255) + 64 * ((n0 >> 5) & 3) + 32 * ((n0 >> 7) & 1)) : n0;
    {
        f32x4 w[8];
#pragma unroll
        for (int i = 0; i < 8; ++i) w[i] = *(const f32x4*)(W + (size_t)(k0 + 8 * i + (lane >> 3)) * ldw + c0 + 4 * (lane & 7));
#pragma unroll
        for (int i = 0; i < 8; ++i) { const int kk = 8 * i + (lane >> 3); const float g = gain ? gain[k0 + kk] : 1.f; float* d = scr + kk * 33 + 4 * (lane & 7);
            d[0] = w[i][0] * g; d[1] = w[i][1] * g; d[2] = w[i][2] * g; d[3] = w[i][3] * g; }
    }
    const int c = lane & 7;
#pragma unroll
    for (int j = 0; j < 4; ++j) { const int n = (lane >> 3) + 8 * j; const float* s = scr + (8 * c) * 33 + n;
        u32x4 o; o.x = cvtpk(s[0 * 33], s[1 * 33]); o.y = cvtpk(s[2 * 33], s[3 * 33]); o.z = cvtpk(s[4 * 33], s[5 * 33]); o.w = cvtpk(s[6 * 33], s[7 * 33]);
        *(u32x4*)(WT + (size_t)(n0 + n) * DM + k0 + 8 * c) = o; }
}

struct Args {
    const float* x; const int* pos; const float* norm_g; const float* fox_w_in; const float* fox_b_f; const float* fox_qn; const float* fox_kn; const float* fox_w_out;
    const float* dsw_w_in; const float* dsw_qn; const float* dsw_kn; const float* dsw_w_out; float* out; unsigned char* ws;
};

DI void prologue(const Args& a, unsigned char* lds) {
    const int tid = mk_tid(), lane = tid & 63, wave = tid >> 6;
    const int gw = blockIdx.x * NWAVES + wave, NGW = gridDim.x * NWAVES;
    float* scr = (float*)(lds + wave * 8448);
    unsigned char* ws = a.ws;
    constexpr int I_FOX = 16 * (4096 / 32), I_DSW = 16 * (10240 / 32), I_OUT = 16 * (1024 / 32);
    constexpr int NITEMS = 2 * I_FOX + 2 * I_DSW + 4 * I_OUT;
    for (int it = gw; it < NITEMS; it += NGW) {
        int r = it;
        if (r < 2 * I_FOX) { const int j = r / I_FOX; transpose_item(a.fox_w_in + (size_t)j * DM * FOX_IN, FOX_IN, 4096, (bf16_t*)(ws + WS_WFOX) + (size_t)j * 4096 * DM, a.norm_g + 2 * j * DM, true, scr, r % I_FOX, lane); continue; }
        r -= 2 * I_FOX;
        if (r < 2 * I_DSW) { const int j = r / I_DSW; transpose_item(a.dsw_w_in + (size_t)j * DM * DSW_IN, DSW_IN, 10240, (bf16_t*)(ws + WS_WDSW) + (size_t)j * 10240 * DM, a.norm_g + (2 * j + 1) * DM, true, scr, r % I_DSW, lane); continue; }
        r -= 2 * I_DSW;
        { const int L = r / I_OUT, j = L >> 1; const float* W = (L & 1) ? a.dsw_w_out + (size_t)j * DM * DM : a.fox_w_out + (size_t)j * DM * DM;
          transpose_item(W, DM, 1024, (bf16_t*)(ws + WS_WOUT) + (size_t)L * DM * DM, nullptr, false, scr, r % I_OUT, lane); }
    }
    { bf16_t* wf = (bf16_t*)(ws + WS_WF);
      for (int e = blockIdx.x * NTHREADS + tid; e < 2 * 16 * DM; e += gridDim.x * NTHREADS) {
          const int j = e >> 14, h = (e >> 10) & 15, k = e & 1023;
          const float v = a.norm_g[2 * j * DM + k] * a.fox_w_in[(size_t)j * DM * FOX_IN + (size_t)k * FOX_IN + 4096 + h];
          const unsigned hi = cvtpk(v, 0.f) & 0xffffu; const float r = v - __uint_as_float(hi << 16);
          wf[(size_t)(j * 2 + 0) * 16 * DM + h * DM + k] = (bf16_t)hi; wf[(size_t)(j * 2 + 1) * 16 * DM + h * DM + k] = (bf16_t)(cvtpk(r, 0.f) & 0xffffu); } }
    { float* rot = (float*)(ws + WS_ROT);
      const double invf[8] = {1.0, 0.19392274474868576, 0.03760603093086393, 0.007292664737217109, 0.001414213562373095, 0.0002742481756762073, 5.318295896944988e-05, 1.031338537721246e-05};
      for (int e = blockIdx.x * NTHREADS + tid; e < MTOK * 8; e += gridDim.x * NTHREADS) {
          const int t = e >> 3, i = e & 7;
          double f = 1.0;
#pragma unroll
          for (int q = 0; q < 8; ++q) f = (i == q) ? invf[q] : f;
          const double ang = (double)a.pos[t] * f;
          const double k2 = __builtin_rint(ang * 0.15915494309189535);
          const float r = (float)(ang - k2 * 6.283185307179586);
          rot[(size_t)t * 16 + i] = cosf(r); rot[(size_t)t * 16 + 8 + i] = sinf(r); } }
    { bf16_t* xb = (bf16_t*)(ws + WS_XB); float* ssq = (float*)(ws + WS_SSQ);
      for (int m = gw; m < MTOK; m += 2 * NGW) {
          const int m2 = m + NGW; const bool two = m2 < MTOK;
          const f32x4* xr = (const f32x4*)(a.x + (size_t)m * DM) + lane; const f32x4* xr2 = (const f32x4*)(a.x + (size_t)(two ? m2 : m) * DM) + lane;
          f32x4 v[4], w2[4];
#pragma unroll
          for (int j = 0; j < 4; ++j) { v[j] = xr[64 * j]; w2[j] = xr2[64 * j]; }
          float s = 0.f, s2 = 0.f;
#pragma unroll
          for (int j = 0; j < 4; ++j) { s += (v[j][0] * v[j][0] + v[j][1] * v[j][1]) + (v[j][2] * v[j][2] + v[j][3] * v[j][3]); s2 += (w2[j][0] * w2[j][0] + w2[j][1] * w2[j][1]) + (w2[j][2] * w2[j][2] + w2[j][3] * w2[j][3]);
              u32x2 w; w.x = cvtpk(v[j][0], v[j][1]); w.y = cvtpk(v[j][2], v[j][3]); *((u32x2*)(xb + (size_t)m * DM) + lane + 64 * j) = w;
              if (two) { u32x2 q; q.x = cvtpk(w2[j][0], w2[j][1]); q.y = cvtpk(w2[j][2], w2[j][3]); *((u32x2*)(xb + (size_t)m2 * DM) + lane + 64 * j) = q; } }
          s = wave_sum(s); s2 = wave_sum(s2);
          if (lane < 16) { ssq[(size_t)m * 16 + lane] = lane == 0 ? s : 0.f; if (two) ssq[(size_t)m2 * 16 + lane] = lane == 0 ? s2 : 0.f; }
      } }
}

DI void fg_step(const float* x, const bf16_t* wf, const float* b_f, float* cloc, float* ctot, unsigned char* lds) {
    const int tid = mk_tid(), lane = tid & 63, wave = tid >> 6;
    float* ls = (float*)lds;
    float* part = (float*)(lds + 4096);
    for (int chunk = blockIdx.x; chunk < MTOK / 64; chunk += gridDim.x) {
        {
            const int tile = wave & 3, kh = wave >> 2;
            const int row = lane & 15, kg = lane >> 4; const size_t tok = (size_t)chunk * 64 + tile * 16 + row;
            const float* xp = x + tok * DM + 512 * kh + 8 * kg; const bf16_t* wh = wf + (size_t)row * DM + 512 * kh + 8 * kg; const bf16_t* wl = wh + 16 * DM;
            f32x4 acc = {0.f, 0.f, 0.f, 0.f}; float ss = 0.f;
#pragma unroll 8
            for (int s = 0; s < 16; ++s) {
                const f32x4 a0 = *(const f32x4*)(xp + 32 * s), a1 = *(const f32x4*)(xp + 32 * s + 4);
                ss += (a0[0] * a0[0] + a0[1] * a0[1]) + (a0[2] * a0[2] + a0[3] * a0[3]) + (a1[0] * a1[0] + a1[1] * a1[1]) + (a1[2] * a1[2] + a1[3] * a1[3]);
                u32x4 h; h.x = cvtpk(a0[0], a0[1]); h.y = cvtpk(a0[2], a0[3]); h.z = cvtpk(a1[0], a1[1]); h.w = cvtpk(a1[2], a1[3]);
                u32x4 l; l.x = cvtpk(a0[0] - bf_lo(h.x), a0[1] - bf_hi(h.x)); l.y = cvtpk(a0[2] - bf_lo(h.y), a0[3] - bf_hi(h.y));
                l.z = cvtpk(a1[0] - bf_lo(h.z), a1[1] - bf_hi(h.z)); l.w = cvtpk(a1[2] - bf_lo(h.w), a1[3] - bf_hi(h.w));
                const bf16x8 ah = __builtin_bit_cast(bf16x8, h), al = __builtin_bit_cast(bf16x8, l);
                const bf16x8 bh = *(const bf16x8*)(wh + 32 * s), bl = *(const bf16x8*)(wl + 32 * s);
                acc = __builtin_amdgcn_mfma_f32_16x16x32_bf16(ah, bh, acc, 0, 0, 0);
                acc = __builtin_amdgcn_mfma_f32_16x16x32_bf16(ah, bl, acc, 0, 0, 0);
                acc = __builtin_amdgcn_mfma_f32_16x16x32_bf16(al, bh, acc, 0, 0, 0);
            }
            if (kh == 1) { float* pp = part + (tile * 64 + lane) * 5; pp[0] = acc[0]; pp[1] = acc[1]; pp[2] = acc[2]; pp[3] = acc[3]; pp[4] = ss; }
            __syncthreads();
            if (kh == 0) {
                const float* pp = part + (tile * 64 + lane) * 5;
                acc[0] += pp[0]; acc[1] += pp[1]; acc[2] += pp[2]; acc[3] += pp[3]; ss += pp[4];
                ss += __shfl_xor(ss, 16); ss += __shfl_xor(ss, 32);
                const float rstd = rsqrtf(ss * (1.f / DM) + EPS);
                const float bf = b_f[lane & 15];
#pragma unroll
                for (int i = 0; i < 4; ++i) {
                    const int t = 4 * kg + i; const float rs = __shfl(rstd, t);
                    const float f = acc[i] * rs + bf;
                    const float v = fminf(f, 0.f) - log1pf(__expf(-fabsf(f)));
                    ls[(tile * 16 + t) * 16 + (lane & 15)] = v;
                }
            }
        }
        __syncthreads();
#pragma unroll
        for (int hh = 0; hh < 2; ++hh) {
            const int head = 2 * wave + hh; float v = ls[lane * 16 + head];
#pragma unroll
            for (int o = 1; o < 64; o <<= 1) { const float t = __shfl_up(v, o); if (lane >= o) v += t; }
            cloc[((size_t)chunk * 64 + lane) * 16 + head] = v;
            if (lane == 63) ctot[(size_t)chunk * 16 + head] = v;
        }
        __syncthreads();
    }
}

template <int N> DI float dpp_row_ror(float v) { return __uint_as_float((unsigned)__builtin_amdgcn_update_dpp((int)__float_as_uint(v), (int)__float_as_uint(v), 0x120 + N, 0xf, 0xf, false)); }
DI float wave_min64(float v) {
    v = fminf(v, dpp_row_ror<8>(v)); v = fminf(v, dpp_row_ror<4>(v)); v = fminf(v, dpp_row_ror<2>(v)); v = fminf(v, dpp_row_ror<1>(v));
    { auto r = __builtin_amdgcn_permlane16_swap(__float_as_uint(v), __float_as_uint(v), false, false); v = fminf(__uint_as_float(r[0]), __uint_as_float(r[1])); }
    { auto r = __builtin_amdgcn_permlane32_swap(__float_as_uint(v), __float_as_uint(v), false, false); v = fminf(__uint_as_float(r[0]), __uint_as_float(r[1])); }
    return v;
}
DI float xhalf_max(float m) { auto rr = __builtin_amdgcn_permlane32_swap(__float_as_uint(m), __float_as_uint(m), false, false); return fmaxf(__uint_as_float(rr[0]), __uint_as_float(rr[1])); }
DI float max3f(float a, float b, float c) { return fmaxf(fmaxf(a, b), c); }
DI float max2f(float a, float b) { return fmaxf(a, b); }
DI float sub_f(float a, float b) { return a - b; }
DI float add_f(float a, float b) { return a + b; }
DI float mul_f(float a, float b) { return a * b; }
DI float exp_sum16(f32x16& p, float mx) {
    float s0 = 0.f, s1 = 0.f;
#pragma unroll
    for (int i = 0; i < 16; i += 2) { p[i] = fexp2(sub_f(p[i], mx)); p[i + 1] = fexp2(sub_f(p[i + 1], mx)); s0 = add_f(s0, p[i]); s1 = add_f(s1, p[i + 1]); }
    return s0 + s1;
}
DI void scale16(f32x16& o, float a) {
#pragma unroll
    for (int i = 0; i < 16; ++i) o[i] = mul_f(o[i], a);
}

constexpr int FA_ROWB = 144;
constexpr int FA_K = 0, FA_V = 64 * FA_ROWB, FA_BIAS = 2 * 64 * FA_ROWB, FA_BUF = FA_BIAS + 256;
constexpr int FA_PRE = 2 * FA_BUF;

#define LDS_BAR() do { asm volatile("s_waitcnt lgkmcnt(0)" ::: "memory"); __builtin_amdgcn_s_barrier(); asm volatile("" ::: "memory"); } while (0)
DI void fox_compute(const unsigned char* cur, int t, int NT, int qpos, const bf16x8 (&qr)[4], f32x16& o0, f32x16& o1, float& mrow, float& lsum, int r32, int hi, int trb) {
    f32x16 p0, p1;
    { const float* bias = (const float*)(cur + FA_BIAS) + 4 * hi;
#pragma unroll
      for (int g = 0; g < 4; ++g) { const f32x4 b0 = *(const f32x4*)(bias + 8 * g), b1 = *(const f32x4*)(bias + 32 + 8 * g);
#pragma unroll
          for (int e = 0; e < 4; ++e) { p0[4 * g + e] = b0[e]; p1[4 * g + e] = b1[e]; } } }
    { const unsigned char* kb = cur + FA_K + r32 * FA_ROWB + 16 * hi;
      bf16x8 kf0[4], kf1[4];
#pragma unroll
      for (int s = 0; s < 4; ++s) { kf0[s] = *(const bf16x8*)(kb + 32 * s); kf1[s] = *(const bf16x8*)(kb + 32 * FA_ROWB + 32 * s); }
      __builtin_amdgcn_s_setprio(1);
#pragma unroll
      for (int s = 0; s < 4; ++s) { p0 = MFMA32(kf0[s], qr[s], p0); p1 = MFMA32(kf1[s], qr[s], p1); }
      __builtin_amdgcn_s_setprio(0); }
    if (t >= NT - 4) {
        asm volatile("" ::: "memory");
        const int kb0 = 64 * t;
#pragma unroll
        for (int i = 0; i < 16; ++i) { const int kv = kb0 + crow(i, hi); if (kv > qpos) p0[i] = -INFINITY; if (kv + 32 > qpos) p1[i] = -INFINITY; }
    }
    float ma = mrow, mb = max2f(p0[0], p1[0]);
#pragma unroll
    for (int i = 1; i < 16; i += 2) { ma = max3f(ma, p0[i], p1[i]); if (i + 1 < 16) mb = max3f(mb, p0[i + 1], p1[i + 1]); }
    float mx = max2f(ma, mb);
    mx = xhalf_max(mx);
    const float alpha = fexp2(mrow - mx); mrow = mx;
    const float rs = exp_sum16(p0, mx) + exp_sum16(p1, mx);
    lsum = lsum * alpha + rs;
    if (__builtin_amdgcn_ballot_w64(alpha != 1.f) != 0ull) {
        scale16(o0, alpha); scale16(o1, alpha);
    }
    const bf16x8 pf0 = pack8(p0[0], p0[1], p0[2], p0[3], p0[4], p0[5], p0[6], p0[7]), pf1 = pack8(p0[8], p0[9], p0[10], p0[11], p0[12], p0[13], p0[14], p0[15]);
    const bf16x8 pf2 = pack8(p1[0], p1[1], p1[2], p1[3], p1[4], p1[5], p1[6], p1[7]), pf3 = pack8(p1[8], p1[9], p1[10], p1[11], p1[12], p1[13], p1[14], p1[15]);
    const unsigned char* vb = cur + FA_V + trb;
#pragma unroll
    for (int ks = 0; ks < 4; ++ks) {
        const bf16x8 pf = ks == 0 ? pf0 : (ks == 1 ? pf1 : (ks == 2 ? pf2 : pf3));
        const s16x4 a0l = vtr(vb + ks * 16 * FA_ROWB), a0h = vtr(vb + (ks * 16 + 8) * FA_ROWB);
        const s16x4 a1l = vtr(vb + ks * 16 * FA_ROWB + 64), a1h = vtr(vb + (ks * 16 + 8) * FA_ROWB + 64);
        const bf16x8 va0 = __builtin_shufflevector(a0l, a0h, 0, 1, 2, 3, 4, 5, 6, 7), va1 = __builtin_shufflevector(a1l, a1h, 0, 1, 2, 3, 4, 5, 6, 7);
        o0 = MFMA32(va0, pf, o0); o1 = MFMA32(va1, pf, o1);
    }
}

DI void fox_unit(unsigned char* lds, int b, int h, int qb, const bf16_t* Q, const bf16_t* K, const bf16_t* V, const bf16_t* G, bf16_t* AO, const float* cloc, const float* ctot, const float* qn, const float* kn) {
    const int tid = mk_tid(), lane = tid & 63, wid = __builtin_amdgcn_readfirstlane(tid >> 6), r32 = lane & 31, hi = lane >> 5;
    const size_t rowbase = (size_t)b * SEQ; const int q0 = qb * 256, NT = 4 * (qb + 1);
    float* pre = (float*)(lds + FA_PRE);
    if (wid == 0) {
        float v = lane < 32 ? ctot[((size_t)b * 32 + (lane & 31)) * 16 + h] : 0.f; float inc = v;
#pragma unroll
        for (int o = 1; o < 32; o <<= 1) { const float t = __shfl_up(inc, o); if (lane >= o) inc += t; }
        if (lane < 32) pre[lane] = inc - v;
    }
    float qkB;
    { float gq = fabsf(qn[lane]), gk = fabsf(kn[lane]);
#pragma unroll
      for (int o = 1; o < 64; o <<= 1) { gq = fmaxf(gq, __shfl_xor(gq, o)); gk = fmaxf(gk, __shfl_xor(gk, o)); }
      qkB = 64.f * C2 * gq * gk * 1.02f; }
    float* red = (float*)(lds + FA_PRE + 128);
    const int key = tid >> 3, ch = tid & 7;
    const bf16_t* kp = K + (rowbase + key) * DM + h * HD + ch * 8; const bf16_t* vp = V + (rowbase + key) * DM + h * HD + ch * 8;
    const float* cp = cloc + (rowbase + (tid & 63)) * 16 + h;
    bf16x8 qr[4];
    const int qpos = q0 + 32 * wid + r32;
    { const bf16_t* qp = Q + (rowbase + qpos) * DM + h * HD + 8 * hi;
#pragma unroll
      for (int s = 0; s < 4; ++s) qr[s] = *(const bf16x8*)(qp + 16 * s); }
    u32x2 gw8[2][4];
    { const size_t orow_ = (rowbase + qpos) * DM + h * HD + 4 * hi;
#pragma unroll
      for (int mt = 0; mt < 2; ++mt)
#pragma unroll
          for (int g = 0; g < 4; ++g) gw8[mt][g] = *(const u32x2*)(G + orow_ + 32 * mt + 8 * g); }
    u32x4 kA, vA, kB, vB, kC, vC, kD, vD; float cA, cB, cC, cD;
#define FOX_LOAD(t_, kx, vx, cx) do { const int tc_ = (t_) < NT ? NT - 1 - (t_) : 0; const size_t adv_ = (size_t)tc_ * 64 * DM; kx = *(const u32x4*)(kp + adv_); vx = *(const u32x4*)(vp + adv_); cx = cp[(size_t)tc_ * 64 * 16]; } while (0)
#define FOX_WRITE(t_, kx, vx, cx) do { unsigned char* bw_ = lds + ((t_) & 1) * FA_BUF; *(u32x4*)(bw_ + FA_K + key * FA_ROWB + ch * 16) = kx; *(u32x4*)(bw_ + FA_V + key * FA_ROWB + ch * 16) = vx; \
        if (tid < 64) ((float*)(bw_ + FA_BIAS))[tid] = -(cx + pre[NT - 1 - (t_)]) * LOG2E; } while (0)
    FOX_LOAD(0, kA, vA, cA); FOX_LOAD(1, kB, vB, cB); FOX_LOAD(2, kC, vC, cC); FOX_LOAD(3, kD, vD, cD);
    LDS_BAR();
    FOX_WRITE(0, kA, vA, cA);
    LDS_BAR();
    f32x16 o0 = {}, o1 = {}; float mrow = -1e30f, lsum = 0.f;
    const int trb = ((lane >> 4) & 1) * 32 + (lane & 3) * 8 + (4 * hi + ((lane & 15) >> 2)) * FA_ROWB;
    const int tlast = (q0 + 32 * wid + 31) >> 6;
#define FOX_BODY(t_, kl, vl, cl, kw, vw, cw) do { \
        FOX_LOAD((t_) + 4, kl, vl, cl); \
        const bool wskip_ = (t_) >= 4 && __builtin_amdgcn_readfirstlane((int)(qkB + ((const float*)(lds + ((t_) & 1) * FA_BUF + FA_BIAS))[63] < wprev - 160.f));     \
        if (NT - 1 - (t_) <= tlast && !wskip_) fox_compute(lds + ((t_) & 1) * FA_BUF, NT - 1 - (t_), NT, qpos, qr, o0, o1, mrow, lsum, r32, hi, trb); \
        if ((t_) + 1 < NT) FOX_WRITE((t_) + 1, kw, vw, cw); \
        { const float wm_ = wave_min64(mrow); if (lane == 0) red[((t_) & 1) * 8 + wid] = wm_; wprev = wm_; } \
        LDS_BAR(); \
        if ((t_) >= 3 && (t_) + 1 < NT) { \
            const f32x4 r0_ = *(const f32x4*)(red + ((t_) & 1) * 8), r1_ = *(const f32x4*)(red + ((t_) & 1) * 8 + 4); \
            const float mn_ = fminf(fminf(fminf(r0_[0], r0_[1]), fminf(r0_[2], r0_[3])), fminf(fminf(r1_[0], r1_[1]), fminf(r1_[2], r1_[3]))); \
            const float bn_ = ((const float*)(lds + (((t_) + 1) & 1) * FA_BUF + FA_BIAS))[63]; \
            if (__builtin_amdgcn_readfirstlane((int)(qkB + bn_ < mn_ - 160.f))) goto fox_done; } } while (0)
    float wprev = -1e30f;
#pragma unroll 1
    for (int t = 0; t < NT; t += 4) {
        FOX_BODY(t, kA, vA, cA, kB, vB, cB);
        FOX_BODY(t + 1, kB, vB, cB, kC, vC, cC);
        FOX_BODY(t + 2, kC, vC, cC, kD, vD, cD);
        FOX_BODY(t + 3, kD, vD, cD, kA, vA, cA);
    }
fox_done:
#undef FOX_BODY
#undef FOX_LOAD
#undef FOX_WRITE
    lsum += __shfl_xor(lsum, 32);
    const float inv = 1.f / lsum;
    const size_t orow = (rowbase + qpos) * DM + h * HD + 4 * hi;
#pragma unroll
    for (int mt = 0; mt < 2; ++mt)
#pragma unroll
        for (int g = 0; g < 4; ++g) {
            const size_t off = orow + 32 * mt + 8 * g;
            const u32x2 gw = gw8[mt][g];
            const f32x16& o = mt ? o1 : o0;
            u32x2 w; w.x = cvtpk(o[4 * g] * inv * silu(bf_lo(gw.x)), o[4 * g + 1] * inv * silu(bf_hi(gw.x)));
            w.y = cvtpk(o[4 * g + 2] * inv * silu(bf_lo(gw.y)), o[4 * g + 3] * inv * silu(bf_hi(gw.y)));
            *(u32x2*)(AO + off) = w;
        }
}
DI void fox_attn_phase(unsigned char* lds, const bf16_t* proj, bf16_t* AO, const float* cloc, const float* ctot, const float* qn, const float* kn, unsigned* ctr) {
    const size_t mats = (size_t)MTOK * DM;
    volatile LAS int* slot = (volatile LAS int*)((LAS unsigned char*)lds + FA_PRE + 256);
    for (;;) {
        __syncthreads();
        if (threadIdx.x == 0) { const unsigned v = __hip_atomic_fetch_add(ctr, 1u, __ATOMIC_RELAXED, __HIP_MEMORY_SCOPE_AGENT); *slot = (int)v; }
        __syncthreads();
        const int it = __builtin_amdgcn_readfirstlane(*slot);
        if (it >= 1024) break;
        const int qb = 7 - (it >> 7), bh = it & 127, b = bh >> 4, h = bh & 15;
        fox_unit(lds, b, h, qb, proj, proj + mats, proj + 2 * mats, proj + 3 * mats, AO, cloc, ctot, qn, kn);
    }
}

constexpr int DA_OG = 0, DA_LSE2 = 2 * 256 * 128, DA_LSE = 3 * 256 * 128, DA_VST = DA_LSE + 3 * 256 * 4, DA_VROW = 144, DA_VBYTES = 32 * DA_VROW;
static_assert(DA_VST + 8 * DA_VBYTES <= 140000, "dswa LDS map");

DI void dsw_group(const bf16_t* Qh, const bf16_t* Kh, const bf16_t* Vh, int R, int cls, int e0w, int tq, int jmin, unsigned char* st, const unsigned char* kfb, int trb,
                  int lrow, int lch, int r32, int hi, f32x16& o0, f32x16& o1, float& mrow, float& lsum) {
    bf16x8 qr[4];
    const int sh = R == 1 ? 9 : (R == 4 ? 7 : 5);
#define DSW_ROW(el_) ((((el_) >> sh) << 9) + (cls << sh) + ((el_) & ((1 << sh) - 1)))
    { const bf16_t* qp = Qh + (size_t)DSW_ROW(e0w + r32) * DM + 8 * hi;
#pragma unroll
      for (int s = 0; s < 4; ++s) qr[s] = *(const bf16x8*)(qp + 16 * s); }
    o0 = f32x16{}; o1 = f32x16{}; mrow = -1e30f; lsum = 0.f;
    u32x4 kn[4], vn[4];
#define DSW_LOAD(jj_, kd, vd) do { _Pragma("unroll") for (int it_ = 0; it_ < 4; ++it_) { const size_t o_ = (size_t)DSW_ROW(e0w - 128 + 32 * (jj_) + 8 * it_ + lrow) * DM + 8 * lch; \
        kd[it_] = *(const u32x4*)(Kh + o_); vd[it_] = *(const u32x4*)(Vh + o_); } } while (0)
#define DSW_STAGE(src) do { _Pragma("unroll") for (int it_ = 0; it_ < 4; ++it_) *(u32x4*)(st + (8 * it_ + lrow) * DA_VROW + 16 * lch) = src[it_]; } while (0)
    DSW_LOAD(jmin, kn, vn);
    const int ql = r32 - 4 * hi;
#pragma unroll 1
    for (int jj = jmin; jj < 5; ++jj) {
        u32x4 kc[4], vc[4];
#pragma unroll
        for (int s = 0; s < 4; ++s) { kc[s] = kn[s]; vc[s] = vn[s]; }
        if (jj + 1 < 5) DSW_LOAD(jj + 1, kn, vn);
        DSW_STAGE(kc);
        f32x16 p = {};
        { bf16x8 kf_[4];
#pragma unroll
          for (int s = 0; s < 4; ++s) kf_[s] = *(const bf16x8*)(kfb + 32 * s);
          __builtin_amdgcn_s_setprio(1);
#pragma unroll
          for (int s = 0; s < 4; ++s) p = MFMA32(kf_[s], qr[s], p);
          __builtin_amdgcn_s_setprio(0); }
        DSW_STAGE(vc);
        if (jj == 0) {
            asm volatile("" ::: "memory");
#pragma unroll
            for (int i = 0; i < 16; ++i) p[i] = ((i & 3) + 8 * (i >> 2)) >= ql ? p[i] : -INFINITY;
        } else if (jj == 4) {
            asm volatile("" ::: "memory");
#pragma unroll
            for (int i = 0; i < 16; ++i) p[i] = ((i & 3) + 8 * (i >> 2)) <= ql ? p[i] : -INFINITY;
        }
        float ma = mrow, mb = max2f(p[0], p[1]);
#pragma unroll
        for (int i = 2; i < 16; i += 4) { ma = max3f(ma, p[i], p[i + 1]); if (i + 2 < 16) mb = max3f(mb, p[i + 2], p[i + 3]); }
        float mx = max2f(ma, mb);
        mx = xhalf_max(mx);
        const float alpha = fexp2(mrow - mx); mrow = mx;
        const float rs = exp_sum16(p, mx);
        lsum = lsum * alpha + rs;
        const bf16x8 pf0 = pack8(p[0], p[1], p[2], p[3], p[4], p[5], p[6], p[7]), pf1 = pack8(p[8], p[9], p[10], p[11], p[12], p[13], p[14], p[15]);
        if (__builtin_amdgcn_ballot_w64(alpha != 1.f) != 0ull) { scale16(o0, alpha); scale16(o1, alpha); }
        const unsigned char* vb = st + trb;
#pragma unroll
        for (int ks = 0; ks < 2; ++ks) {
            const bf16x8 pf = ks == 0 ? pf0 : pf1;
            const s16x4 a0l = vtr(vb + ks * 16 * DA_VROW), a0h = vtr(vb + (ks * 16 + 8) * DA_VROW);
            const s16x4 a1l = vtr(vb + ks * 16 * DA_VROW + 64), a1h = vtr(vb + (ks * 16 + 8) * DA_VROW + 64);
            const bf16x8 va0 = __builtin_shufflevector(a0l, a0h, 0, 1, 2, 3, 4, 5, 6, 7), va1 = __builtin_shufflevector(a1l, a1h, 0, 1, 2, 3, 4, 5, 6, 7);
            o0 = MFMA32(va0, pf, o0); o1 = MFMA32(va1, pf, o1);
        }
    }
#undef DSW_LOAD
#undef DSW_STAGE
#undef DSW_ROW
    lsum += __shfl_xor(lsum, 32);
}

DI void dsw_unit(unsigned char* lds, int bl, int sb, int h, const bf16_t* proj, size_t mats, bf16_t* AO) {
    const int tid = mk_tid(), lane = tid & 63, wid = __builtin_amdgcn_readfirstlane(tid >> 6), r32 = lane & 31, hi = lane >> 5;
    const size_t rowbase = (size_t)bl * SEQ; const int T0s = sb * 512;
    unsigned char* st = lds + DA_VST + wid * DA_VBYTES;
    const int lrow = lane >> 3, lch = lane & 7;
    const int trb = ((lane >> 4) & 1) * 32 + (lane & 3) * 8 + (4 * hi + ((lane & 15) >> 2)) * DA_VROW;
    const unsigned char* kfb = st + r32 * DA_VROW + 16 * hi;
    f32x16 o0, o1; float mrow, lsum;
#pragma unroll 1
    for (int qt = 0; qt < 2; ++qt) {
        const int cls = 2 * wid + qt, e0w = T0s >> 4, tq = T0s + 16 * r32 + cls;
        int jmin = 4 - (e0w >> 5); jmin = jmin < 0 ? 0 : jmin;
        const size_t hb = rowbase * DM + h * HD;
        dsw_group(proj + 2 * mats + hb, proj + 5 * mats + hb, proj + 8 * mats + hb, 16, cls, e0w, tq, jmin, st, kfb, trb, lrow, lch, r32, hi, o0, o1, mrow, lsum);
        const float inv = 1.f / lsum;
        bf16_t* orow = AO + (rowbase + tq) * DM + h * HD + 4 * hi;
#pragma unroll
        for (int mt = 0; mt < 2; ++mt)
#pragma unroll
            for (int q = 0; q < 4; ++q) { const f32x16& o = mt ? o1 : o0;
                u32x2 w; w.x = cvtpk(o[4 * q] * inv, o[4 * q + 1] * inv); w.y = cvtpk(o[4 * q + 2] * inv, o[4 * q + 3] * inv);
                *(u32x2*)(orow + 32 * mt + 8 * q) = w; }
        if (hi == 0) ((float*)(lds + DA_LSE2))[tq - T0s] = mrow + __log2f(lsum);
    }
    __syncthreads();
#pragma unroll 1
    for (int half = 0; half < 2; ++half) {
        const int T0 = T0s + 256 * half;
        const size_t coff = (rowbase + T0 + (tid >> 1)) * DM + h * HD + 32 * (tid & 1);
        u32x4 gt4[4];
#pragma unroll
        for (int c = 0; c < 4; ++c) gt4[c] = *(const u32x4*)(proj + 9 * mats + coff + 8 * c);
#pragma unroll 1
        for (int g = 0; g < 2; ++g) {
            const size_t hb = rowbase * DM + h * HD;
            int e0w, cls, tq, R;
            if (g == 0) { R = 1; cls = 0;       e0w = T0 + 32 * wid;                 tq = e0w + r32; }
            else        { R = 4; cls = wid & 3; e0w = (T0 >> 2) + 32 * (wid >> 2);   tq = 4 * (e0w + r32) + cls; }
            int jmin = 4 - (e0w >> 5); jmin = jmin < 0 ? 0 : jmin;
            dsw_group(proj + (size_t)g * mats + hb, proj + (size_t)(3 + g) * mats + hb, proj + (size_t)(6 + g) * mats + hb, R, cls, e0w, tq, jmin, st, kfb, trb, lrow, lch, r32, hi, o0, o1, mrow, lsum);
            const float inv = 1.f / lsum;
            const int tl = tq - T0;
            unsigned char* og = lds + DA_OG + g * 32768 + tl * 128 + 8 * hi;
#pragma unroll
            for (int mt = 0; mt < 2; ++mt)
#pragma unroll
                for (int q = 0; q < 4; ++q) { const f32x16& o = mt ? o1 : o0;
                    u32x2 w; w.x = cvtpk(o[4 * q] * inv, o[4 * q + 1] * inv); w.y = cvtpk(o[4 * q + 2] * inv, o[4 * q + 3] * inv);
                    *(u32x2*)(og + 64 * mt + 16 * q) = w; }
            if (hi == 0) ((float*)(lds + DA_LSE))[g * 256 + tl] = mrow + __log2f(lsum);
        }
        __syncthreads();
        {
            const int tl = tid >> 1, dh = tid & 1;
            const float* lse = (const float*)(lds + DA_LSE);
            const float l0 = lse[tl], l1 = lse[256 + tl], l2 = ((const float*)(lds + DA_LSE2))[256 * half + tl], mx = fmaxf(l0, fmaxf(l1, l2));
            float w0 = fexp2(l0 - mx), w1 = fexp2(l1 - mx), w2 = fexp2(l2 - mx); const float inv = 1.f / (w0 + w1 + w2); w0 *= inv; w1 *= inv; w2 *= inv;
#pragma unroll
            for (int c = 0; c < 4; ++c) {
                const u32x4 a = *(const u32x4*)(lds + DA_OG + tl * 128 + 64 * dh + 16 * c), bq = *(const u32x4*)(lds + DA_OG + 32768 + tl * 128 + 64 * dh + 16 * c),
                            cq = *(const u32x4*)(AO + coff + 8 * c), gt = gt4[c];
                u32x4 w;
#pragma unroll
                for (int e = 0; e < 4; ++e) {
                    const float lo = (w0 * bf_lo(a[e]) + w1 * bf_lo(bq[e]) + w2 * bf_lo(cq[e])) * silu(bf_lo(gt[e]));
                    const float hv = (w0 * bf_hi(a[e]) + w1 * bf_hi(bq[e]) + w2 * bf_hi(cq[e])) * silu(bf_hi(gt[e]));
                    w[e] = cvtpk(lo, hv);
                }
                *(u32x4*)(AO + coff + 8 * c) = w;
            }
        }
        __syncthreads();
    }
}
DI void dsw_attn_phase(unsigned char* lds, const bf16_t* proj, bf16_t* AO_half) {
    const size_t mats = (size_t)(MTOK / 2) * DM;
    for (int u = blockIdx.x; u < 256; u += gridDim.x) dsw_unit(lds, u >> 6, (u >> 4) & 3, u & 15, proj, mats, AO_half);
}

typedef __attribute__((address_space(1))) unsigned gu32;
#define XB_TMO      128
#define XB_XCNT(j)  (256  + 64 * (j))
#define XB_XSUB(j)  (1280 + 64 * (j))
#define XB_XGEN(j)  (2304 + 64 * (j))
#define XB_TOP      3328
#define XB_TOPGEN   3392
#define XCD_BAR_WORDS 3456
#define XB_SPIN_CAP (1u << 18)

__device__ __forceinline__ unsigned xb_ld(unsigned* p)              { return __hip_atomic_load(p, __ATOMIC_RELAXED, __HIP_MEMORY_SCOPE_AGENT); }
__device__ __forceinline__ unsigned xb_add(unsigned* p, unsigned v) { return __hip_atomic_fetch_add(p, v, __ATOMIC_RELAXED, __HIP_MEMORY_SCOPE_AGENT); }
__device__ __forceinline__ unsigned xb_xcc_id() { return (unsigned)__builtin_amdgcn_s_getreg((3 << 11) | 20) & 0xFu; }
#define XB_SPIN(cond, bar) do { unsigned _sp = 0; while (cond) { __builtin_amdgcn_s_sleep(1); \
    if ((++_sp & 255u) == 0u) { if (xb_ld(&(bar)[XB_TMO])) break; if (_sp > XB_SPIN_CAP) { atomicAdd(&(bar)[XB_TMO], 1u); break; } } } } while (0)

struct XcdBarrier {
    unsigned* bar; unsigned x;
    volatile LAS unsigned* st;
};

__device__ __forceinline__ XcdBarrier xcd_barrier_post(unsigned* bar, volatile LAS unsigned* st) {
    XcdBarrier b; b.bar = bar; b.x = xb_xcc_id(); b.st = st;
    if (threadIdx.x == 0) (void)xb_add(&bar[XB_XCNT(b.x)], 1u);
    return b;
}
__device__ __forceinline__ void xcd_barrier_complete(unsigned* bar, unsigned x, unsigned& nloc, unsigned& nx) {
    const unsigned G = gridDim.x * gridDim.y * gridDim.z;
    unsigned sum, cnt, mine, sp = 0u;
    for (;;) {
        sum = 0u; cnt = 0u; mine = 0u;
#pragma unroll
        for (unsigned j = 0; j < 16; ++j) { const unsigned c = xb_ld(&bar[XB_XCNT(j)]); sum += c; cnt += (c > 0u) ? 1u : 0u; mine = (j == x) ? c : mine; }
        if (sum == G) break;
        __builtin_amdgcn_s_sleep(1);
        if ((++sp & 255u) == 0u) { if (xb_ld(&bar[XB_TMO])) break; if (sp > XB_SPIN_CAP) { atomicAdd(&bar[XB_TMO], 1u); break; } }
    }
    nloc = mine > 0u ? mine : 1u; nx = cnt > 0u ? cnt : 1u;
}

__device__ __forceinline__ void xcd_barrier(const XcdBarrier& b) {
    asm volatile("s_waitcnt vmcnt(0)" ::: "memory");
    __syncthreads();
    if (threadIdx.x == 0) {
        unsigned* bar = b.bar;
        __builtin_amdgcn_s_waitcnt(0);
        unsigned nloc = b.st[0], nx = b.st[1];
        if (nloc == 0u) { xcd_barrier_complete(bar, b.x, nloc, nx); b.st[0] = nloc; b.st[1] = nx; }
        const unsigned old = xb_add(&bar[XB_XSUB(b.x)], 1u);
        const unsigned gen = old / nloc;
        if (old + 1u == (gen + 1u) * nloc) {
            __builtin_amdgcn_fence(__ATOMIC_RELEASE, "agent");
            asm volatile("s_waitcnt vmcnt(0)" ::: "memory");
            const unsigned og = xb_add(&bar[XB_TOP], 1u);
            const unsigned tg = og / nx;
            if (og + 1u == (tg + 1u) * nx) xb_add(&bar[XB_TOPGEN], 1u);
            else XB_SPIN(xb_ld(&bar[XB_TOPGEN]) == tg, bar);
            __builtin_amdgcn_fence(__ATOMIC_ACQUIRE, "agent");
            xb_add(&bar[XB_XGEN(b.x)], 1u);
            asm volatile("s_waitcnt vmcnt(0)" ::: "memory");
        } else {
            XB_SPIN(xb_ld(&bar[XB_XGEN(b.x)]) == gen, bar);
            __builtin_amdgcn_fence(__ATOMIC_ACQUIRE, "agent");
            asm volatile("s_waitcnt vmcnt(0)" ::: "memory");
        }
    }
    __syncthreads();
}

__global__ void __launch_bounds__(NTHREADS, 2) fwd_megakernel(Args a) {
    extern __shared__ __attribute__((aligned(16))) unsigned char lds[];
    cg::grid_group grid = cg::this_grid();
    unsigned char* ws = a.ws;
    bf16_t* XB = (bf16_t*)(ws + WS_XB); bf16_t* AO = (bf16_t*)(ws + WS_AO); bf16_t* PROJ = (bf16_t*)(ws + WS_PROJ);
    float* SSQ = (float*)(ws + WS_SSQ); float* ROT = (float*)(ws + WS_ROT); float* CLOC = (float*)(ws + WS_CLOC); float* CTOT = (float*)(ws + WS_CTOT);
    PG8_LAS unsigned char* ldsl = (PG8_LAS unsigned char*)lds;

    volatile LAS unsigned* MISC = (volatile LAS unsigned*)((LAS unsigned char*)lds + LDS_BYTES - 64);
    if (threadIdx.x < 16) MISC[threadIdx.x] = 0u;
    __syncthreads();
    for (int rep = 0; rep < REP_PRO; ++rep) prologue(a, lds);
    if (blockIdx.x == 0) for (int w = threadIdx.x; w < (int)(CTL_ZERO_BYTES / 4); w += NTHREADS) __hip_atomic_store((unsigned*)(ws + WS_CTL) + w, 0u, __ATOMIC_RELAXED, __HIP_MEMORY_SCOPE_AGENT);
    grid.sync();
    XcdBarrier bar = xcd_barrier_post((unsigned*)(ws + WS_CTL), MISC);
#pragma unroll 1
    for (int layer = 0; layer < 4; ++layer) {
        const int j = layer >> 1; const bool dsw = layer & 1;
        const float* xcur = layer == 0 ? a.x : a.out;
        const int nhalf = dsw ? 2 : 1;
#pragma unroll 1
        for (int half = 0; half < nhalf; ++half) {
            if (!dsw) for (int rep = 0; rep < REP_FG; ++rep) fg_step(xcur, (const bf16_t*)(ws + WS_WF) + (size_t)j * 2 * 16 * DM, a.fox_b_f + j * NH, CLOC, CTOT, lds);
            for (int rep = 0; rep < REP_PROJ; ++rep) {
                const int Mg = dsw ? MTOK / 2 : MTOK, Ng = dsw ? 10240 : 4096, row_off = half * (MTOK / 2);
                const bf16_t* Bt = dsw ? (const bf16_t*)(ws + WS_WDSW) + (size_t)j * 10240 * DM : (const bf16_t*)(ws + WS_WFOX) + (size_t)j * 4096 * DM;
                pg8::Gemm g{XB + (size_t)row_off * DM, Bt, Mg, Ng, DM}; pg8::StaticOrder S; S.init(Mg, Ng, (int)gridDim.x, (int)blockIdx.x);
                EpiProj E{PROJ, (size_t)Mg * DM, SSQ, ROT, row_off, dsw ? a.dsw_qn + j * 3 * HD : a.fox_qn + j * HD, dsw ? a.dsw_kn + j * 3 * HD : a.fox_kn + j * HD, dsw ? 3 : 1};
                pg8::gemm_phase<EpiProj, pg8::StaticOrder, true, true>(ldsl, g, S, E);
            }
            xcd_barrier(bar);
            if (!dsw) for (int rep = 0; rep < REP_FOX; ++rep) fox_attn_phase(lds, PROJ, AO, CLOC, CTOT, a.fox_qn + j * HD, a.fox_kn + j * HD, (unsigned*)(ws + WS_CTL) + 3600 + j);
            if (dsw) for (int rep = 0; rep < REP_DSW; ++rep) dsw_attn_phase(lds, PROJ, AO + (size_t)half * (MTOK / 2) * DM);
            xcd_barrier(bar);
        }
        {
            pg8::Gemm g{AO, (const bf16_t*)(ws + WS_WOUT) + (size_t)layer * DM * DM, MTOK, DM, DM}; pg8::StaticOrder S; S.init(MTOK, DM, (int)gridDim.x, (int)blockIdx.x);
            EpiOut E{xcur, a.out, XB, SSQ, layer == 3 ? 1 : 0};
            pg8::gemm_phase<EpiOut, pg8::StaticOrder, true, true>(ldsl, g, S, E);
        }
        if (layer < 3) for (int rep = 0; rep < REP_SYNC; ++rep) xcd_barrier(bar);
    }
}

extern "C" void kernel_launch(void* const* d_in, const int* in_sizes, int n_in, void* d_out, int out_size, void* d_ws, size_t ws_size, hipStream_t stream) {
    static int grid_blocks = 0;
    if (grid_blocks == 0) {
        if (n_in != 12 || in_sizes[0] != MTOK * DM || out_size != MTOK * DM || ws_size < WS_END) {
            fprintf(stderr, "kernel_launch: unexpected shapes (n_in %d, in0 %d, out %d, ws %zu < %zu); nothing launched\n", n_in, n_in > 0 ? in_sizes[0] : -1, out_size, ws_size, (size_t)WS_END); grid_blocks = -1; return; }
        int dev = 0, cus = 0, per_cu = 0;
        hipGetDevice(&dev); hipDeviceGetAttribute(&cus, hipDeviceAttributeMultiprocessorCount, dev);
        if (hipFuncSetAttribute((const void*)fwd_megakernel, hipFuncAttributeMaxDynamicSharedMemorySize, LDS_BYTES) != hipSuccess) { fprintf(stderr, "kernel_launch: hipFuncSetAttribute failed\n"); grid_blocks = -1; return; }
        if (hipOccupancyMaxActiveBlocksPerMultiprocessor(&per_cu, (const void*)fwd_megakernel, NTHREADS, LDS_BYTES) != hipSuccess || per_cu < 1) { fprintf(stderr, "kernel_launch: occupancy query failed (%d)\n", per_cu); grid_blocks = -1; return; }
        grid_blocks = cus * per_cu;
    }
    if (grid_blocks < 0) return;
    Args a{};
    a.x = (const float*)d_in[0]; a.pos = (const int*)d_in[1]; a.norm_g = (const float*)d_in[2]; a.fox_w_in = (const float*)d_in[3]; a.fox_b_f = (const float*)d_in[4];
    a.fox_qn = (const float*)d_in[5]; a.fox_kn = (const float*)d_in[6]; a.fox_w_out = (const float*)d_in[7]; a.dsw_w_in = (const float*)d_in[8]; a.dsw_qn = (const float*)d_in[9];
    a.dsw_kn = (const float*)d_in[10]; a.dsw_w_out = (const float*)d_in[11]; a.out = (float*)d_out; a.ws = (unsigned char*)d_ws;
    void* args[] = {&a};
    hipError_t e = hipLaunchCooperativeKernel((const void*)fwd_megakernel, dim3(grid_blocks), dim3(NTHREADS), args, LDS_BYTES, stream);
    if (e != hipSuccess) fprintf(stderr, "kernel_launch: cooperative launch failed: %s (grid %d)\n", hipGetErrorString(e), grid_blocks);
}
```

```cpp
#include <hip/hip_runtime.h>
#include <hip/hip_cooperative_groups.h>
#include <cstdio>
#include <cstdint>
namespace cg = cooperative_groups;
#define REP_PRO 1
#define REP_FG 1
#define REP_PROJ 1
#define REP_FOX 1
#define REP_DSW 1
#define REP_SYNC 1
__device__ __forceinline__ int mk_tid() { int t = threadIdx.x; asm volatile("" : "+v"(t)); return t; }
namespace pg8 {
#define PG8_LAS __attribute__((address_space(3)))
typedef unsigned short bf16_t;
typedef short bf16x8 __attribute__((ext_vector_type(8)));
typedef float f32x4 __attribute__((ext_vector_type(4)));
typedef unsigned u32x4 __attribute__((ext_vector_type(4)));
constexpr int BM = 256, BK = 64, HALF = 128, HTB = HALF * BK * 2  , STAGE_BYTES = 8 * HTB, NXCD = 8, WGM = 8;

__host__ __device__ __forceinline__ int lds_byte(int r, int c) { const int st = (r >> 4) * 2 + (c >> 5), rr = r & 15, cc = c & 31, ob = rr * 64 + cc * 2; return st * 1024 + (ob ^ (((ob >> 9) & 1) << 5)); }
__host__ __device__ __forceinline__ void stage_rc(int b, int& R, int& C) { const int st = b / 1024, sb = b % 1024, swz = sb ^ (((sb >> 9) & 1) << 5); R = (st >> 1) * 16 + swz / 64; C = (st & 1) * 32 + (swz % 64) / 2; }
__host__ __device__ __forceinline__ int perm32(int rho) { const int n = rho >> 4, i = rho & 15; return 8 * (i >> 2) + 4 * n + (i & 3); }

struct Unit { int pm, pn; };
struct Gemm { const bf16_t* A; const bf16_t* Bt; int M, N, K; };

struct StaticOrder {
    int nM, nN, nwg, G, c;
    __host__ __device__ void init(int M, int N, int G_, int c_) { nM = M / BM; nN = N / BM; nwg = nM * nN; G = G_; c = c_; }
    __host__ __device__ bool next(int i, Unit& u) const {
        const long L = (long)i * G + c; if (L >= nwg) return false;
        int wgid = (int)L; { const int q = nwg / NXCD, r = nwg % NXCD, xcd = wgid % NXCD, off = wgid / NXCD; wgid = (xcd < r ? xcd * (q + 1) : r * (q + 1) + (xcd - r) * q) + off; }
        const int nig = WGM * nN, gid = wgid / nig, fm = gid * WGM, gsz = (nM - fm) < WGM ? (nM - fm) : WGM;
        u.pm = fm + ((wgid % nig) % gsz); u.pn = (wgid % nig) / gsz; return true;
    }
    __device__ __forceinline__ void a_ready(const Unit&) const {}
    __device__ __forceinline__ void done(const Unit&) const {}
};

__device__ __forceinline__ unsigned cvt_pk_bf16(float lo, float hi) { unsigned r; asm volatile("v_cvt_pk_bf16_f32 %0, %1, %2" : "=v"(r) : "v"(lo), "v"(hi)); return r; }
template <class Epi, class Sched, bool ALIGN_EPI = false, bool SP2 = false>
__device__ __forceinline__ void gemm_phase(PG8_LAS unsigned char* lds, const Gemm g, const Sched& S, const Epi& E) {
    const int tid = mk_tid(), wid = __builtin_amdgcn_readfirstlane(tid >> 6), lane = tid & 63, wr = wid >> 2, wc = wid & 3, fr = lane & 15, fq = lane >> 4;
    const int K = g.K, nt = K / BK;
    unsigned voffA[2], voffB[2];
#pragma unroll
    for (int i = 0; i < 2; ++i) { int R, C; stage_rc(tid * 16 + i * 8192, R, C); const int Rb = Epi::PERM ? ((R & ~31) + perm32(R & 31)) : R;
        voffA[i] = (unsigned)(R * K + C) * 2u; voffB[i] = (unsigned)(Rb * K + C) * 2u; }
    const size_t kstep = (size_t)(BK * 2);
    const size_t hstep = (size_t)HALF * K * 2;
    const size_t tstep = 2 * hstep;
    const unsigned ldsw = (unsigned)wid * 1024u;
    const int aoff = lds_byte(wr * 64 + fr, fq * 8), boff = lds_byte(wc * 32 + fr, fq * 8);
#define PG8_SA(b, h) (((b) * 2 + (h)) * HTB)
#define PG8_SB(b, h) ((4 + (b) * 2 + (h)) * HTB)
#define PG8_STAGE(bufoff, gbase, voff) do { _Pragma("unroll") for (int _i = 0; _i < 2; ++_i) \
        __builtin_amdgcn_global_load_lds((const unsigned*)((const char*)(gbase) + (voff)[_i]), (PG8_LAS unsigned*)(lds + (bufoff) + ldsw + _i * 8192), 16, 0, 0); } while (0)
#define PG8_LDA(dst, b, h) do { _Pragma("unroll") for (int m = 0; m < 4; ++m) _Pragma("unroll") for (int k = 0; k < 2; ++k) dst[m][k] = *(const PG8_LAS bf16x8*)(lds + PG8_SA(b, h) + aoff + m * 2048 + k * 1024); } while (0)
#define PG8_LDB(dst, b, h) do { _Pragma("unroll") for (int n = 0; n < 2; ++n) _Pragma("unroll") for (int k = 0; k < 2; ++k) dst[n][k] = *(const PG8_LAS bf16x8*)(lds + PG8_SB(b, h) + boff + n * 2048 + k * 1024); } while (0)
#define PG8_MMA(ai, bj, At, Bt) do { __builtin_amdgcn_s_setprio(1); _Pragma("unroll") for (int m = 0; m < 4; ++m) _Pragma("unroll") for (int n = 0; n < 2; ++n) _Pragma("unroll") for (int k = 0; k < 2; ++k) \
        acc[ai][bj][m][n] = __builtin_amdgcn_mfma_f32_16x16x32_bf16(Bt[n][k], At[m][k], acc[ai][bj][m][n], 0, 0, 0); __builtin_amdgcn_s_setprio(0); } while (0)
#define PG8_WAIT_V(n) asm volatile("s_waitcnt vmcnt(" #n ")" ::: "memory")
#define PG8_WAIT_L(n) asm volatile("s_waitcnt lgkmcnt(" #n ")" ::: "memory")
#define PG8_BAR __builtin_amdgcn_s_barrier()
#define PG8_SCHED __builtin_amdgcn_sched_barrier(0)
    Unit cur, nxt; int ui = 0;
    if (!S.next(0, cur)) return;
    f32x4 acc[2][2][4][2];
#pragma unroll
    for (int a = 0; a < 2; ++a)
#pragma unroll
        for (int b = 0; b < 2; ++b)
#pragma unroll
            for (int m = 0; m < 4; ++m)
#pragma unroll
                for (int n = 0; n < 2; ++n) acc[a][b][m][n] = (f32x4){0.f, 0.f, 0.f, 0.f};
    bf16x8 At[4][2], B0[2][2], B1[2][2];
    const char* cA = (const char*)g.A + (size_t)cur.pm * tstep; const char* cB = (const char*)g.Bt + (size_t)cur.pn * tstep;
    S.a_ready(cur);
    if constexpr (SP2) {
        PG8_STAGE(PG8_SB(0, 0), cB, voffB); PG8_STAGE(PG8_SB(0, 1), cB + hstep, voffB); PG8_STAGE(PG8_SA(0, 0), cA, voffA); PG8_STAGE(PG8_SA(0, 1), cA + hstep, voffA);
        if (wr == 1) PG8_BAR;
        PG8_WAIT_V(2); PG8_BAR;
        PG8_STAGE(PG8_SB(1, 0), cB + kstep, voffB); PG8_STAGE(PG8_SA(1, 0), cA + kstep, voffA); PG8_STAGE(PG8_SB(1, 1), cB + hstep + kstep, voffB);
        PG8_WAIT_V(6); PG8_BAR;
    } else {
        PG8_STAGE(PG8_SB(0, 0), cB, voffB); PG8_STAGE(PG8_SA(0, 0), cA, voffA); PG8_STAGE(PG8_SB(0, 1), cB + hstep, voffB); PG8_STAGE(PG8_SA(0, 1), cA + hstep, voffA);
        if (wr == 1) PG8_BAR;
        PG8_WAIT_V(4); PG8_BAR;
        PG8_STAGE(PG8_SB(1, 0), cB + kstep, voffB); PG8_STAGE(PG8_SA(1, 0), cA + kstep, voffA); PG8_STAGE(PG8_SB(1, 1), cB + hstep + kstep, voffB);
        PG8_WAIT_V(6); PG8_BAR;
    }
    for (;;) {
        const bool has_next = S.next(ui + 1, nxt);
        const char* nA = has_next ? (const char*)g.A + (size_t)nxt.pm * tstep : cA; const char* nB = has_next ? (const char*)g.Bt + (size_t)nxt.pn * tstep : cB;
        for (int t = 0; t < nt; t += 2) {
            const bool last = (t == nt - 2);
            const char* a1 = cA + (size_t)(t + 1) * kstep;
            const char* a2 = last ? nA : cA + (size_t)(t + 2) * kstep; const char* b2 = last ? nB : cB + (size_t)(t + 2) * kstep;
            const char* a3 = a2 + kstep; const char* b3 = b2 + kstep;
            if (last && has_next) S.a_ready(nxt);
            if constexpr (SP2) {
            PG8_LDB(B0, 0, 0); PG8_LDB(B1, 0, 1); PG8_SCHED; PG8_LDA(At, 0, 0); PG8_STAGE(PG8_SA(1, 1), a1 + hstep, voffA);
            PG8_WAIT_V(8); PG8_WAIT_L(0); PG8_BAR; PG8_MMA(0, 0, At, B0); PG8_MMA(0, 1, At, B1); PG8_BAR; PG8_SCHED;
            PG8_LDA(At, 0, 1); PG8_STAGE(PG8_SB(0, 0), b2, voffB); PG8_STAGE(PG8_SB(0, 1), b2 + hstep, voffB); PG8_STAGE(PG8_SA(0, 0), a2, voffA);
            PG8_WAIT_V(8); PG8_WAIT_L(0); PG8_BAR; PG8_MMA(1, 0, At, B0); PG8_MMA(1, 1, At, B1); PG8_BAR; PG8_SCHED;
            PG8_LDB(B0, 1, 0); PG8_LDB(B1, 1, 1); PG8_SCHED; PG8_LDA(At, 1, 0); PG8_STAGE(PG8_SA(0, 1), a2 + hstep, voffA);
            PG8_WAIT_V(8); PG8_WAIT_L(0); PG8_BAR; PG8_MMA(0, 0, At, B0); PG8_MMA(0, 1, At, B1); PG8_BAR; PG8_SCHED;
            PG8_LDA(At, 1, 1); PG8_STAGE(PG8_SB(1, 0), b3, voffB); PG8_STAGE(PG8_SB(1, 1), b3 + hstep, voffB); PG8_STAGE(PG8_SA(1, 0), a3, voffA);
            PG8_WAIT_V(8); PG8_WAIT_L(0); PG8_BAR; PG8_MMA(1, 0, At, B0); PG8_MMA(1, 1, At, B1); PG8_BAR; PG8_SCHED;
            } else {
            PG8_LDB(B0, 0, 0); PG8_SCHED; PG8_LDA(At, 0, 0); PG8_STAGE(PG8_SA(1, 1), a1 + hstep, voffA);
            PG8_WAIT_L(8); PG8_BAR; PG8_WAIT_L(0); PG8_MMA(0, 0, At, B0); PG8_BAR; PG8_SCHED;
            PG8_LDB(B1, 0, 1); PG8_STAGE(PG8_SB(0, 0), b2, voffB);
            PG8_BAR; PG8_WAIT_L(0); PG8_MMA(0, 1, At, B1); PG8_BAR;
            PG8_LDA(At, 0, 1); PG8_STAGE(PG8_SA(0, 0), a2, voffA);
            PG8_BAR; PG8_WAIT_L(0); PG8_MMA(1, 0, At, B0); PG8_BAR; PG8_SCHED;
            PG8_STAGE(PG8_SB(0, 1), b2 + hstep, voffB);
            PG8_WAIT_V(6); PG8_BAR; PG8_MMA(1, 1, At, B1); PG8_BAR;
            PG8_LDB(B0, 1, 0); PG8_SCHED; PG8_LDA(At, 1, 0); PG8_STAGE(PG8_SA(0, 1), a2 + hstep, voffA);
            PG8_WAIT_L(8); PG8_BAR; PG8_WAIT_L(0); PG8_MMA(0, 0, At, B0); PG8_BAR; PG8_SCHED;
            PG8_LDB(B1, 1, 1); PG8_STAGE(PG8_SB(1, 0), b3, voffB);
            PG8_BAR; PG8_WAIT_L(0); PG8_MMA(0, 1, At, B1); PG8_BAR;
            PG8_LDA(At, 1, 1); PG8_STAGE(PG8_SA(1, 0), a3, voffA);
            PG8_BAR; PG8_WAIT_L(0); PG8_MMA(1, 0, At, B0); PG8_BAR; PG8_SCHED;
            PG8_STAGE(PG8_SB(1, 1), b3 + hstep, voffB);
            PG8_WAIT_V(6); PG8_BAR; PG8_MMA(1, 1, At, B1); PG8_BAR;
            }
        }
        if constexpr (ALIGN_EPI) { if (wr == 0) PG8_BAR; }
        if constexpr (!Epi::AFTER_DRAIN) { E(acc, cur, wr, wc, fr, fq); S.done(cur); }
        if (!has_next) break;
#pragma unroll
        for (int a = 0; a < 2; ++a)
#pragma unroll
            for (int b = 0; b < 2; ++b)
#pragma unroll
                for (int m = 0; m < 4; ++m)
#pragma unroll
                    for (int n = 0; n < 2; ++n) acc[a][b][m][n] = (f32x4){0.f, 0.f, 0.f, 0.f};
        cur = nxt; cA = nA; cB = nB; ++ui;
        if constexpr (ALIGN_EPI) { if (wr == 1) PG8_BAR; }
    }
    PG8_WAIT_V(0);
    if constexpr (!ALIGN_EPI) { if (wr == 0) PG8_BAR; }
    PG8_BAR;
    if constexpr (Epi::AFTER_DRAIN) { E.fused(acc, cur, wr, wc, fr, fq, lds, wid, lane); S.done(cur); }
#undef PG8_SA
#undef PG8_SB
#undef PG8_STAGE
#undef PG8_LDA
#undef PG8_LDB
#undef PG8_MMA
#undef PG8_WAIT_V
#undef PG8_WAIT_L
#undef PG8_BAR
#undef PG8_SCHED
}
}

#define DI __device__ __forceinline__
#define LAS __attribute__((address_space(3)))
typedef unsigned short bf16_t;
typedef short bf16x8 __attribute__((ext_vector_type(8)));
typedef short s16x4 __attribute__((ext_vector_type(4)));
typedef float f32x4 __attribute__((ext_vector_type(4)));
typedef float f32x16 __attribute__((ext_vector_type(16)));
typedef unsigned u32x4 __attribute__((ext_vector_type(4)));
typedef unsigned u32x2 __attribute__((ext_vector_type(2)));
typedef float f32x2_t __attribute__((ext_vector_type(2)));
typedef __bf16 bf16x2_t __attribute__((ext_vector_type(2)));
typedef short v4i16_t __attribute__((ext_vector_type(4)));

constexpr int NTHREADS = 512, NWAVES = 8;
constexpr int BATCH = 8, SEQ = 2048, DM = 1024, NH = 16, HD = 64, MTOK = BATCH * SEQ;
constexpr int FOX_IN = 4 * DM + NH, DSW_IN = 10 * DM;
constexpr float EPS = 1e-6f;
constexpr float LOG2E = 1.4426950408889634f;
constexpr float C2 = 0.125f * LOG2E;
constexpr int LDS_BYTES = 147456;

constexpr size_t MiB = 1u << 20;
constexpr size_t WS_CTL = 0, CTL_ZERO_BYTES = 16384;
constexpr size_t WS_ROT = 1 * MiB;
constexpr size_t WS_SSQ = 2 * MiB;
constexpr size_t WS_CLOC = 3 * MiB;
constexpr size_t WS_CTOT = 4 * MiB;
constexpr size_t WS_WF = 5 * MiB;
constexpr size_t WS_WFOX = 8 * MiB;
constexpr size_t WS_WDSW = 24 * MiB;
constexpr size_t WS_WOUT = 64 * MiB;
constexpr size_t WS_XB = 72 * MiB;
constexpr size_t WS_AO = 104 * MiB;
constexpr size_t WS_PROJ = 136 * MiB;
constexpr size_t WS_END = 296 * MiB;

DI unsigned cvtpk(float lo, float hi) { f32x2_t v = {lo, hi}; bf16x2_t b = __builtin_convertvector(v, bf16x2_t); return __builtin_bit_cast(unsigned, b); }
DI float bf_lo(unsigned w) { return __uint_as_float(w << 16); }
DI float bf_hi(unsigned w) { return __uint_as_float(w & 0xffff0000u); }
DI float fexp2(float x) { return __builtin_amdgcn_exp2f(x); }
DI float silu(float g) { return g / (1.f + __expf(-g)); }
DI s16x4 vtr(const void* p) { return __builtin_bit_cast(s16x4, __builtin_amdgcn_ds_read_tr16_b64_v4i16((LAS v4i16_t*)p)); }
DI int crow(int i, int hi) { return (i & 3) + 8 * (i >> 2) + 4 * hi; }
#define MFMA32(a, b, c) __builtin_amdgcn_mfma_f32_32x32x16_bf16((a), (b), (c), 0, 0, 0)
DI bf16x8 pack8(float a0, float a1, float a2, float a3, float a4, float a5, float a6, float a7) {
    u32x4 w; w.x = cvtpk(a0, a1); w.y = cvtpk(a2, a3); w.z = cvtpk(a4, a5); w.w = cvtpk(a6, a7); return __builtin_bit_cast(bf16x8, w);
}

struct EpiProj {
    static constexpr bool PERM = true, AFTER_DRAIN = false;
    bf16_t* out; size_t mats;
    const float* ssq; const float* rot; int row_off;
    const float* qg; const float* kg; int nq;
    DI void operator()(const f32x4 (&acc)[2][2][4][2], const pg8::Unit& u, int wr, int wc, int fr, int fq) const {
        const int mat = u.pn >> 2, head = (u.pn & 3) * 4 + wc;
        const int kind = mat < nq ? 1 : (mat < 2 * nq ? 2 : 0);
        const float* gp = kind == 1 ? qg + 64 * mat : kg + 64 * (mat - nq);
        f32x4 gn[2][2];
#pragma unroll
        for (int bj = 0; bj < 2; ++bj)
#pragma unroll
            for (int n = 0; n < 2; ++n) gn[bj][n] = kind ? *(const f32x4*)(gp + 32 * bj + 8 * fq + 4 * n) : (f32x4){1.f, 1.f, 1.f, 1.f};
        const float qs = kind == 1 ? C2 : 1.f;
        bf16_t* obase = out + (size_t)mat * mats + head * 64 + 8 * fq;
        const bool rotl = (nq == 3) && kind && fq < 2;
        float rstd[8];
#pragma unroll
        for (int hb = 0; hb < 2; ++hb) {
            f32x4 sp[4];
#pragma unroll
            for (int r = 0; r < 4; ++r) { const int row = u.pm * 256 + hb * 128 + wr * 64 + r * 16 + fr; sp[r] = *(const f32x4*)(ssq + (size_t)(row_off + row) * 16 + 4 * fq); }
#pragma unroll
            for (int r = 0; r < 4; ++r) { float t = (sp[r][0] + sp[r][1]) + (sp[r][2] + sp[r][3]); t += __shfl_xor(t, 16); t += __shfl_xor(t, 32); rstd[4 * hb + r] = rsqrtf(t * (1.f / DM) + EPS); }
        }
        f32x4 rc0 = {}, rc1 = {}, rs0 = {}, rs1 = {};
        if (rotl) { const float* rp = rot + (size_t)(row_off + u.pm * 256 + wr * 64 + fr) * 16; rc0 = *(const f32x4*)rp; rc1 = *(const f32x4*)(rp + 4); rs0 = *(const f32x4*)(rp + 8); rs1 = *(const f32x4*)(rp + 12); }
#pragma unroll
        for (int r = 0; r < 8; ++r) {
            const int ai = r >> 2, m = r & 3;
            const int row = u.pm * 256 + ai * 128 + wr * 64 + m * 16 + fr;
            const f32x4 c0 = rc0, c1 = rc1, s0 = rs0, s1 = rs1;
            if (rotl && r < 7) { const int rn = u.pm * 256 + ((r + 1) >> 2) * 128 + wr * 64 + ((r + 1) & 3) * 16 + fr; const float* rp = rot + (size_t)(row_off + rn) * 16;
                rc0 = *(const f32x4*)rp; rc1 = *(const f32x4*)(rp + 4); rs0 = *(const f32x4*)(rp + 8); rs1 = *(const f32x4*)(rp + 12); }
            f32x4 v[2][2];
#pragma unroll
            for (int bj = 0; bj < 2; ++bj)
#pragma unroll
                for (int n = 0; n < 2; ++n) v[bj][n] = acc[ai][bj][m][n] * rstd[r];
            if (kind) {
                float ss = 0.f;
#pragma unroll
                for (int bj = 0; bj < 2; ++bj)
#pragma unroll
                    for (int n = 0; n < 2; ++n) ss += (v[bj][n][0] * v[bj][n][0] + v[bj][n][1] * v[bj][n][1]) + (v[bj][n][2] * v[bj][n][2] + v[bj][n][3] * v[bj][n][3]);
                ss += __shfl_xor(ss, 16); ss += __shfl_xor(ss, 32);
                const float hr = rsqrtf(ss * (1.f / HD) + EPS) * qs;
#pragma unroll
                for (int bj = 0; bj < 2; ++bj)
#pragma unroll
                    for (int n = 0; n < 2; ++n) v[bj][n] = v[bj][n] * gn[bj][n] * hr;
                if (nq == 3) {
                    f32x4 o0, o1;
#pragma unroll
                    for (int e = 0; e < 4; ++e) { o0[e] = __shfl_xor(v[0][0][e], 16); o1[e] = __shfl_xor(v[0][1][e], 16); }
                    if (fq == 0) { v[0][0] = v[0][0] * c0 - o0 * s0; v[0][1] = v[0][1] * c1 - o1 * s1; }
                    else if (fq == 1) { v[0][0] = v[0][0] * c0 + o0 * s0; v[0][1] = v[0][1] * c1 + o1 * s1; }
                }
            }
            int prow = row;
            if (nq == 3 && mat < 9) { const int gi = mat % 3;
                if (gi == 1) prow = (row & ~511) + ((row & 3) << 7) + ((row & 511) >> 2);
                else if (gi == 2) prow = (row & ~511) + ((row & 15) << 5) + ((row & 511) >> 4); }
            bf16_t* rowp = obase + (size_t)prow * DM;
#pragma unroll
            for (int bj = 0; bj < 2; ++bj) {
                u32x4 w; w.x = cvtpk(v[bj][0][0], v[bj][0][1]); w.y = cvtpk(v[bj][0][2], v[bj][0][3]); w.z = cvtpk(v[bj][1][0], v[bj][1][1]); w.w = cvtpk(v[bj][1][2], v[bj][1][3]);
                *(u32x4*)(rowp + 32 * bj) = w;
            }
        }
    }
};

struct EpiOut {
    static constexpr bool PERM = false, AFTER_DRAIN = false;
    const float* xin; float* xout; bf16_t* xb; float* ssq; int last;
    DI void operator()(const f32x4 (&acc)[2][2][4][2], const pg8::Unit& u, int wr, int wc, int fr, int fq) const {
        const int col0 = u.pn * 256 + wc * 32 + 4 * fq;
#pragma unroll
        for (int ai = 0; ai < 2; ++ai)
#pragma unroll
            for (int m = 0; m < 4; ++m) {
                const size_t row = (size_t)(u.pm * 256 + ai * 128 + wr * 64 + m * 16 + fr);
                float ss = 0.f;
#pragma unroll
                for (int bj = 0; bj < 2; ++bj)
#pragma unroll
                    for (int n = 0; n < 2; ++n) {
                        const size_t off = row * DM + col0 + bj * 128 + n * 16;
                        const f32x4 xo = *(const f32x4*)(xin + off) + acc[ai][bj][m][n];
                        *(f32x4*)(xout + off) = xo;
                        if (!last) { u32x2 w; w.x = cvtpk(xo[0], xo[1]); w.y = cvtpk(xo[2], xo[3]); *(u32x2*)(xb + off) = w; }
                        ss += (xo[0] * xo[0] + xo[1] * xo[1]) + (xo[2] * xo[2] + xo[3] * xo[3]);
                    }
                ss += __shfl_xor(ss, 16); ss += __shfl_xor(ss, 32);
                if (fq == 0 && !last) ssq[row * 16 + u.pn * 4 + wc] = ss;
            }
    }
};

DI float wave_sum(float v) {
#pragma unroll
    for (int o = 1; o < 64; o <<= 1) v += __shfl_xor(v, o);
    return v;
}
DI void transpose_item(const float* W, int ldw, int N, bf16_t* WT, const float* gain, bool perm, float* scr, int item, int lane) {
    const int nblk = N / 32, kb = item / nblk, nb = item % nblk, k0 = 64 * kb, n0 = 32 * nb;
    const int c0 = perm ? ((n0 & ~255) + 64 * ((n0 >> 5) & 3) + 32 * ((n0 >> 7) & 1)) : n0;
    {
        f32x4 w[8];
#pragma unroll
        for (int i = 0; i < 8; ++i) w[i] = *(const f32x4*)(W + (size_t)(k0 + 8 * i + (lane >> 3)) * ldw + c0 + 4 * (lane & 7));
#pragma unroll
        for (int i = 0; i < 8; ++i) { const int kk = 8 * i + (lane >> 3); const float g = gain ? gain[k0 + kk] : 1.f; float* d = scr + kk * 33 + 4 * (lane & 7);
            d[0] = w[i][0] * g; d[1] = w[i][1] * g; d[2] = w[i][2] * g; d[3] = w[i][3] * g; }
    }
    const int c = lane & 7;
#pragma unroll
    for (int j = 0; j < 4; ++j) { const int n = (lane >> 3) + 8 * j; const float* s = scr + (8 * c) * 33 + n;
        u32x4 o; o.x = cvtpk(s[0 * 33], s[1 * 33]); o.y = cvtpk(s[2 * 33], s[3 * 33]); o.z = cvtpk(s[4 * 33], s[5 * 33]); o.w = cvtpk(s[6 * 33], s[7 * 33]);
        *(u32x4*)(WT + (size_t)(n0 + n) * DM + k0 + 8 * c) = o; }
}

struct Args {
    const float* x; const int* pos; const float* norm_g; const float* fox_w_in; const float* fox_b_f; const float* fox_qn; const float* fox_kn; const float* fox_w_out;
    const float* dsw_w_in; const float* dsw_qn; const float* dsw_kn; const float* dsw_w_out; float* out; unsigned char* ws;
};

DI void prologue(const Args& a, unsigned char* lds) {
    const int tid = mk_tid(), lane = tid & 63, wave = tid >> 6;
    const int gw = blockIdx.x * NWAVES + wave, NGW = gridDim.x * NWAVES;
    float* scr = (float*)(lds + wave * 8448);
    unsigned char* ws = a.ws;
    constexpr int I_FOX = 16 * (4096 / 32), I_DSW = 16 * (10240 / 32), I_OUT = 16 * (1024 / 32);
    constexpr int NITEMS = 2 * I_FOX + 2 * I_DSW + 4 * I_OUT;
    for (int it = gw; it < NITEMS; it += NGW) {
        int r = it;
        if (r < 2 * I_FOX) { const int j = r / I_FOX; transpose_item(a.fox_w_in + (size_t)j * DM * FOX_IN, FOX_IN, 4096, (bf16_t*)(ws + WS_WFOX) + (size_t)j * 4096 * DM, a.norm_g + 2 * j * DM, true, scr, r % I_FOX, lane); continue; }
        r -= 2 * I_FOX;
        if (r < 2 * I_DSW) { const int j = r / I_DSW; transpose_item(a.dsw_w_in + (size_t)j * DM * DSW_IN, DSW_IN, 10240, (bf16_t*)(ws + WS_WDSW) + (size_t)j * 10240 * DM, a.norm_g + (2 * j + 1) * DM, true, scr, r % I_DSW, lane); continue; }
        r -= 2 * I_DSW;
        { const int L = r / I_OUT, j = L >> 1; const float* W = (L & 1) ? a.dsw_w_out + (size_t)j * DM * DM : a.fox_w_out + (size_t)j * DM * DM;
          transpose_item(W, DM, 1024, (bf16_t*)(ws + WS_WOUT) + (size_t)L * DM * DM, nullptr, false, scr, r % I_OUT, lane); }
    }
    { bf16_t* wf = (bf16_t*)(ws + WS_WF);
      for (int e = blockIdx.x * NTHREADS + tid; e < 2 * 16 * DM; e += gridDim.x * NTHREADS) {
          const int j = e >> 14, h = (e >> 10) & 15, k = e & 1023;
          const float v = a.norm_g[2 * j * DM + k] * a.fox_w_in[(size_t)j * DM * FOX_IN + (size_t)k * FOX_IN + 4096 + h];
          const unsigned hi = cvtpk(v, 0.f) & 0xffffu; const float r = v - __uint_as_float(hi << 16);
          wf[(size_t)(j * 2 + 0) * 16 * DM + h * DM + k] = (bf16_t)hi; wf[(size_t)(j * 2 + 1) * 16 * DM + h * DM + k] = (bf16_t)(cvtpk(r, 0.f) & 0xffffu); } }
    { float* rot = (float*)(ws + WS_ROT);
      const double invf[8] = {1.0, 0.19392274474868576, 0.03760603093086393, 0.007292664737217109, 0.001414213562373095, 0.0002742481756762073, 5.318295896944988e-05, 1.031338537721246e-05};
      for (int e = blockIdx.x * NTHREADS + tid; e < MTOK * 8; e += gridDim.x * NTHREADS) {
          const int t = e >> 3, i = e & 7;
          double f = 1.0;
#pragma unroll
          for (int q = 0; q < 8; ++q) f = (i == q) ? invf[q] : f;
          const double ang = (double)a.pos[t] * f;
          const double k2 = __builtin_rint(ang * 0.15915494309189535);
          const float r = (float)(ang - k2 * 6.283185307179586);
          rot[(size_t)t * 16 + i] = cosf(r); rot[(size_t)t * 16 + 8 + i] = sinf(r); } }
    { bf16_t* xb = (bf16_t*)(ws + WS_XB); float* ssq = (float*)(ws + WS_SSQ);
      for (int m = gw; m < MTOK; m += 2 * NGW) {
          const int m2 = m + NGW; const bool two = m2 < MTOK;
          const f32x4* xr = (const f32x4*)(a.x + (size_t)m * DM) + lane; const f32x4* xr2 = (const f32x4*)(a.x + (size_t)(two ? m2 : m) * DM) + lane;
          f32x4 v[4], w2[4];
#pragma unroll
          for (int j = 0; j < 4; ++j) { v[j] = xr[64 * j]; w2[j] = xr2[64 * j]; }
          float s = 0.f, s2 = 0.f;
#pragma unroll
          for (int j = 0; j < 4; ++j) { s += (v[j][0] * v[j][0] + v[j][1] * v[j][1]) + (v[j][2] * v[j][2] + v[j][3] * v[j][3]); s2 += (w2[j][0] * w2[j][0] + w2[j][1] * w2[j][1]) + (w2[j][2] * w2[j][2] + w2[j][3] * w2[j][3]);
              u32x2 w; w.x = cvtpk(v[j][0], v[j][1]); w.y = cvtpk(v[j][2], v[j][3]); *((u32x2*)(xb + (size_t)m * DM) + lane + 64 * j) = w;
              if (two) { u32x2 q; q.x = cvtpk(w2[j][0], w2[j][1]); q.y = cvtpk(w2[j][2], w2[j][3]); *((u32x2*)(xb + (size_t)m2 * DM) + lane + 64 * j) = q; } }
          s = wave_sum(s); s2 = wave_sum(s2);
          if (lane < 16) { ssq[(size_t)m * 16 + lane] = lane == 0 ? s : 0.f; if (two) ssq[(size_t)m2 * 16 + lane] = lane == 0 ? s2 : 0.f; }
      } }
}

DI void fg_step(const float* x, const bf16_t* wf, const float* b_f, float* cloc, float* ctot, unsigned char* lds) {
    const int tid = mk_tid(), lane = tid & 63, wave = tid >> 6;
    float* ls = (float*)lds;
    float* part = (float*)(lds + 4096);
    for (int chunk = blockIdx.x; chunk < MTOK / 64; chunk += gridDim.x) {
        {
            const int tile = wave & 3, kh = wave >> 2;
            const int row = lane & 15, kg = lane >> 4; const size_t tok = (size_t)chunk * 64 + tile * 16 + row;
            const float* xp = x + tok * DM + 512 * kh + 8 * kg; const bf16_t* wh = wf + (size_t)row * DM + 512 * kh + 8 * kg; const bf16_t* wl = wh + 16 * DM;
            f32x4 acc = {0.f, 0.f, 0.f, 0.f}; float ss = 0.f;
#pragma unroll 8
            for (int s = 0; s < 16; ++s) {
                const f32x4 a0 = *(const f32x4*)(xp + 32 * s), a1 = *(const f32x4*)(xp + 32 * s + 4);
                ss += (a0[0] * a0[0] + a0[1] * a0[1]) + (a0[2] * a0[2] + a0[3] * a0[3]) + (a1[0] * a1[0] + a1[1] * a1[1]) + (a1[2] * a1[2] + a1[3] * a1[3]);
                u32x4 h; h.x = cvtpk(a0[0], a0[1]); h.y = cvtpk(a0[2], a0[3]); h.z = cvtpk(a1[0], a1[1]); h.w = cvtpk(a1[2], a1[3]);
                u32x4 l; l.x = cvtpk(a0[0] - bf_lo(h.x), a0[1] - bf_hi(h.x)); l.y = cvtpk(a0[2] - bf_lo(h.y), a0[3] - bf_hi(h.y));
                l.z = cvtpk(a1[0] - bf_lo(h.z), a1[1] - bf_hi(h.z)); l.w = cvtpk(a1[2] - bf_lo(h.w), a1[3] - bf_hi(h.w));
                const bf16x8 ah = __builtin_bit_cast(bf16x8, h), al = __builtin_bit_cast(bf16x8, l);
                const bf16x8 bh = *(const bf16x8*)(wh + 32 * s), bl = *(const bf16x8*)(wl + 32 * s);
                acc = __builtin_amdgcn_mfma_f32_16x16x32_bf16(ah, bh, acc, 0, 0, 0);
                acc = __builtin_amdgcn_mfma_f32_16x16x32_bf16(ah, bl, acc, 0, 0, 0);
                acc = __builtin_amdgcn_mfma_f32_16x16x32_bf16(al, bh, acc, 0, 0, 0);
            }
            if (kh == 1) { float* pp = part + (tile * 64 + lane) * 5; pp[0] = acc[0]; pp[1] = acc[1]; pp[2] = acc[2]; pp[3] = acc[3]; pp[4] = ss; }
            __syncthreads();
            if (kh == 0) {
                const float* pp = part + (tile * 64 + lane) * 5;
                acc[0] += pp[0]; acc[1] += pp[1]; acc[2] += pp[2]; acc[3] += pp[3]; ss += pp[4];
                ss += __shfl_xor(ss, 16); ss += __shfl_xor(ss, 32);
                const float rstd = rsqrtf(ss * (1.f / DM) + EPS);
                const float bf = b_f[lane & 15];
#pragma unroll
                for (int i = 0; i < 4; ++i) {
                    const int t = 4 * kg + i; const float rs = __shfl(rstd, t);
                    const float f = acc[i] * rs + bf;
                    const float v = fminf(f, 0.f) - log1pf(__expf(-fabsf(f)));
                    ls[(tile * 16 + t) * 16 + (lane & 15)] = v;
                }
            }
        }
        __syncthreads();
#pragma unroll
        for (int hh = 0; hh < 2; ++hh) {
            const int head = 2 * wave + hh; float v = ls[lane * 16 + head];
#pragma unroll
            for (int o = 1; o < 64; o <<= 1) { const float t = __shfl_up(v, o); if (lane >= o) v += t; }
            cloc[((size_t)chunk * 64 + lane) * 16 + head] = v;
            if (lane == 63) ctot[(size_t)chunk * 16 + head] = v;
        }
        __syncthreads();
    }
}

template <int N> DI float dpp_row_ror(float v) { return __uint_as_float((unsigned)__builtin_amdgcn_update_dpp((int)__float_as_uint(v), (int)__float_as_uint(v), 0x120 + N, 0xf, 0xf, false)); }
DI float wave_min64(float v) {
    v = fminf(v, dpp_row_ror<8>(v)); v = fminf(v, dpp_row_ror<4>(v)); v = fminf(v, dpp_row_ror<2>(v)); v = fminf(v, dpp_row_ror<1>(v));
    { auto r = __builtin_amdgcn_permlane16_swap(__float_as_uint(v), __float_as_uint(v), false, false); v = fminf(__uint_as_float(r[0]), __uint_as_float(r[1])); }
    { auto r = __builtin_amdgcn_permlane32_swap(__float_as_uint(v), __float_as_uint(v), false, false); v = fminf(__uint_as_float(r[0]), __uint_as_float(r[1])); }
    return v;
}
DI float xhalf_max(float m) { auto rr = __builtin_amdgcn_permlane32_swap(__float_as_uint(m), __float_as_uint(m), false, false); return fmaxf(__uint_as_float(rr[0]), __uint_as_float(rr[1])); }
DI float max3f(float a, float b, float c) { return fmaxf(fmaxf(a, b), c); }
DI float max2f(float a, float b) { return fmaxf(a, b); }
DI float sub_f(float a, float b) { return a - b; }
DI float add_f(float a, float b) { return a + b; }
DI float mul_f(float a, float b) { return a * b; }
DI float exp_sum16(f32x16& p, float mx) {
    float s0 = 0.f, s1 = 0.f;
#pragma unroll
    for (int i = 0; i < 16; i += 2) { p[i] = fexp2(sub_f(p[i], mx)); p[i + 1] = fexp2(sub_f(p[i + 1], mx)); s0 = add_f(s0, p[i]); s1 = add_f(s1, p[i + 1]); }
    return s0 + s1;
}
DI void scale16(f32x16& o, float a) {
#pragma unroll
    for (int i = 0; i < 16; ++i) o[i] = mul_f(o[i], a);
}

constexpr int FA_ROWB = 144;
constexpr int FA_K = 0, FA_V = 64 * FA_ROWB, FA_BIAS = 2 * 64 * FA_ROWB, FA_BUF = FA_BIAS + 256;
constexpr int FA_PRE = 2 * FA_BUF;

#define LDS_BAR() do { asm volatile("s_waitcnt lgkmcnt(0)" ::: "memory"); __builtin_amdgcn_s_barrier(); asm volatile("" ::: "memory"); } while (0)
DI void fox_compute(const unsigned char* cur, int t, int NT, int qpos, const bf16x8 (&qr)[4], f32x16& o0, f32x16& o1, float& mrow, float& lsum, int r32, int hi, int trb) {
    f32x16 p0, p1;
    { const float* bias = (const float*)(cur + FA_BIAS) + 4 * hi;
#pragma unroll
      for (int g = 0; g < 4; ++g) { const f32x4 b0 = *(const f32x4*)(bias + 8 * g), b1 = *(const f32x4*)(bias + 32 + 8 * g);
#pragma unroll
          for (int e = 0; e < 4; ++e) { p0[4 * g + e] = b0[e]; p1[4 * g + e] = b1[e]; } } }
    { const unsigned char* kb = cur + FA_K + r32 * FA_ROWB + 16 * hi;
      bf16x8 kf0[4], kf1[4];
#pragma unroll
      for (int s = 0; s < 4; ++s) { kf0[s] = *(const bf16x8*)(kb + 32 * s); kf1[s] = *(const bf16x8*)(kb + 32 * FA_ROWB + 32 * s); }
      __builtin_amdgcn_s_setprio(1);
#pragma unroll
      for (int s = 0; s < 4; ++s) { p0 = MFMA32(kf0[s], qr[s], p0); p1 = MFMA32(kf1[s], qr[s], p1); }
      __builtin_amdgcn_s_setprio(0); }
    if (t >= NT - 4) {
        asm volatile("" ::: "memory");
        const int kb0 = 64 * t;
#pragma unroll
        for (int i = 0; i < 16; ++i) { const int kv = kb0 + crow(i, hi); if (kv > qpos) p0[i] = -INFINITY; if (kv + 32 > qpos) p1[i] = -INFINITY; }
    }
    float ma = mrow, mb = max2f(p0[0], p1[0]);
#pragma unroll
    for (int i = 1; i < 16; i += 2) { ma = max3f(ma, p0[i], p1[i]); if (i + 1 < 16) mb = max3f(mb, p0[i + 1], p1[i + 1]); }
    float mx = max2f(ma, mb);
    mx = xhalf_max(mx);
    const float alpha = fexp2(mrow - mx); mrow = mx;
    const float rs = exp_sum16(p0, mx) + exp_sum16(p1, mx);
    lsum = lsum * alpha + rs;
    if (__builtin_amdgcn_ballot_w64(alpha != 1.f) != 0ull) {
        scale16(o0, alpha); scale16(o1, alpha);
    }
    const bf16x8 pf0 = pack8(p0[0], p0[1], p0[2], p0[3], p0[4], p0[5], p0[6], p0[7]), pf1 = pack8(p0[8], p0[9], p0[10], p0[11], p0[12], p0[13], p0[14], p0[15]);
    const bf16x8 pf2 = pack8(p1[0], p1[1], p1[2], p1[3], p1[4], p1[5], p1[6], p1[7]), pf3 = pack8(p1[8], p1[9], p1[10], p1[11], p1[12], p1[13], p1[14], p1[15]);
    const unsigned char* vb = cur + FA_V + trb;
#pragma unroll
    for (int ks = 0; ks < 4; ++ks) {
        const bf16x8 pf = ks == 0 ? pf0 : (ks == 1 ? pf1 : (ks == 2 ? pf2 : pf3));
        const s16x4 a0l = vtr(vb + ks * 16 * FA_ROWB), a0h = vtr(vb + (ks * 16 + 8) * FA_ROWB);
        const s16x4 a1l = vtr(vb + ks * 16 * FA_ROWB + 64), a1h = vtr(vb + (ks * 16 + 8) * FA_ROWB + 64);
        const bf16x8 va0 = __builtin_shufflevector(a0l, a0h, 0, 1, 2, 3, 4, 5, 6, 7), va1 = __builtin_shufflevector(a1l, a1h, 0, 1, 2, 3, 4, 5, 6, 7);
        __builtin_amdgcn_s_setprio(1); o0 = MFMA32(va0, pf, o0); o1 = MFMA32(va1, pf, o1); __builtin_amdgcn_s_setprio(0);
    }
}

DI void fox_unit(unsigned char* lds, int b, int h, int qb, const bf16_t* Q, const bf16_t* K, const bf16_t* V, const bf16_t* G, bf16_t* AO, const float* cloc, const float* ctot, const float* qn, const float* kn) {
    const int tid = mk_tid(), lane = tid & 63, wid = __builtin_amdgcn_readfirstlane(tid >> 6), r32 = lane & 31, hi = lane >> 5;
    const size_t rowbase = (size_t)b * SEQ; const int q0 = qb * 256, NT = 4 * (qb + 1);
    float* pre = (float*)(lds + FA_PRE);
    if (wid == 0) {
        float v = lane < 32 ? ctot[((size_t)b * 32 + (lane & 31)) * 16 + h] : 0.f; float inc = v;
#pragma unroll
        for (int o = 1; o < 32; o <<= 1) { const float t = __shfl_up(inc, o); if (lane >= o) inc += t; }
        if (lane < 32) pre[lane] = inc - v;
    }
    float qkB;
    { float gq = fabsf(qn[lane]), gk = fabsf(kn[lane]);
#pragma unroll
      for (int o = 1; o < 64; o <<= 1) { gq = fmaxf(gq, __shfl_xor(gq, o)); gk = fmaxf(gk, __shfl_xor(gk, o)); }
      qkB = 64.f * C2 * gq * gk * 1.02f; }
    float* red = (float*)(lds + FA_PRE + 128);
    const int key = tid >> 3, ch = tid & 7;
    const bf16_t* kp = K + (rowbase + key) * DM + h * HD + ch * 8; const bf16_t* vp = V + (rowbase + key) * DM + h * HD + ch * 8;
    const float* cp = cloc + (rowbase + (tid & 63)) * 16 + h;
    bf16x8 qr[4];
    const int qpos = q0 + 32 * wid + r32;
    { const bf16_t* qp = Q + (rowbase + qpos) * DM + h * HD + 8 * hi;
#pragma unroll
      for (int s = 0; s < 4; ++s) qr[s] = *(const bf16x8*)(qp + 16 * s); }
    u32x2 gw8[2][4];
    { const size_t orow_ = (rowbase + qpos) * DM + h * HD + 4 * hi;
#pragma unroll
      for (int mt = 0; mt < 2; ++mt)
#pragma unroll
          for (int g = 0; g < 4; ++g) gw8[mt][g] = *(const u32x2*)(G + orow_ + 32 * mt + 8 * g); }
    u32x4 kA, vA, kB, vB, kC, vC, kD, vD; float cA, cB, cC, cD;
#define FOX_LOAD(t_, kx, vx, cx) do { const int tc_ = (t_) < NT ? NT - 1 - (t_) : 0; const size_t adv_ = (size_t)tc_ * 64 * DM; kx = *(const u32x4*)(kp + adv_); vx = *(const u32x4*)(vp + adv_); cx = cp[(size_t)tc_ * 64 * 16]; } while (0)
#define FOX_WRITE(t_, kx, vx, cx) do { unsigned char* bw_ = lds + ((t_) & 1) * FA_BUF; *(u32x4*)(bw_ + FA_K + key * FA_ROWB + ch * 16) = kx; *(u32x4*)(bw_ + FA_V + key * FA_ROWB + ch * 16) = vx; \
        if (tid < 64) ((float*)(bw_ + FA_BIAS))[tid] = -(cx + pre[NT - 1 - (t_)]) * LOG2E; } while (0)
    FOX_LOAD(0, kA, vA, cA); FOX_LOAD(1, kB, vB, cB); FOX_LOAD(2, kC, vC, cC); FOX_LOAD(3, kD, vD, cD);
    LDS_BAR();
    FOX_WRITE(0, kA, vA, cA);
    LDS_BAR();
    f32x16 o0 = {}, o1 = {}; float mrow = -1e30f, lsum = 0.f;
    const int trb = ((lane >> 4) & 1) * 32 + (lane & 3) * 8 + (4 * hi + ((lane & 15) >> 2)) * FA_ROWB;
    const int tlast = (q0 + 32 * wid + 31) >> 6;
#define FOX_BODY(t_, kl, vl, cl, kw, vw, cw) do { \
        FOX_LOAD((t_) + 4, kl, vl, cl); \
        const bool wskip_ = (t_) >= 4 && __builtin_amdgcn_readfirstlane((int)(qkB + ((const float*)(lds + ((t_) & 1) * FA_BUF + FA_BIAS))[63] < wprev - 160.f));     \
        if (NT - 1 - (t_) <= tlast && !wskip_) fox_compute(lds + ((t_) & 1) * FA_BUF, NT - 1 - (t_), NT, qpos, qr, o0, o1, mrow, lsum, r32, hi, trb); \
        if ((t_) + 1 < NT) FOX_WRITE((t_) + 1, kw, vw, cw); \
        { const float wm_ = wave_min64(mrow); if (lane == 0) red[((t_) & 1) * 8 + wid] = wm_; wprev = wm_; } \
        LDS_BAR(); \
        if ((t_) >= 3 && (t_) + 1 < NT) { \
            const f32x4 r0_ = *(const f32x4*)(red + ((t_) & 1) * 8), r1_ = *(const f32x4*)(red + ((t_) & 1) * 8 + 4); \
            const float mn_ = fminf(fminf(fminf(r0_[0], r0_[1]), fminf(r0_[2], r0_[3])), fminf(fminf(r1_[0], r1_[1]), fminf(r1_[2], r1_[3]))); \
            const float bn_ = ((const float*)(lds + (((t_) + 1) & 1) * FA_BUF + FA_BIAS))[63]; \
            if (__builtin_amdgcn_readfirstlane((int)(qkB + bn_ < mn_ - 160.f))) goto fox_done; } } while (0)
    float wprev = -1e30f;
#pragma unroll 1
    for (int t = 0; t < NT; t += 4) {
        FOX_BODY(t, kA, vA, cA, kB, vB, cB);
        FOX_BODY(t + 1, kB, vB, cB, kC, vC, cC);
        FOX_BODY(t + 2, kC, vC, cC, kD, vD, cD);
        FOX_BODY(t + 3, kD, vD, cD, kA, vA, cA);
    }
fox_done:
#undef FOX_BODY
#undef FOX_LOAD
#undef FOX_WRITE
    lsum += __shfl_xor(lsum, 32);
    const float inv = 1.f / lsum;
    const size_t orow = (rowbase + qpos) * DM + h * HD + 4 * hi;
#pragma unroll
    for (int mt = 0; mt < 2; ++mt)
#pragma unroll
        for (int g = 0; g < 4; ++g) {
            const size_t off = orow + 32 * mt + 8 * g;
            const u32x2 gw = gw8[mt][g];
            const f32x16& o = mt ? o1 : o0;
            u32x2 w; w.x = cvtpk(o[4 * g] * inv * silu(bf_lo(gw.x)), o[4 * g + 1] * inv * silu(bf_hi(gw.x)));
            w.y = cvtpk(o[4 * g + 2] * inv * silu(bf_lo(gw.y)), o[4 * g + 3] * inv * silu(bf_hi(gw.y)));
            *(u32x2*)(AO + off) = w;
        }
}
DI void fox_attn_phase(unsigned char* lds, const bf16_t* proj, bf16_t* AO, const float* cloc, const float* ctot, const float* qn, const float* kn, unsigned* ctr) {
    const size_t mats = (size_t)MTOK * DM;
    volatile LAS int* slot = (volatile LAS int*)((LAS unsigned char*)lds + FA_PRE + 256);
    for (;;) {
        __syncthreads();
        if (threadIdx.x == 0) { const unsigned v = __hip_atomic_fetch_add(ctr, 1u, __ATOMIC_RELAXED, __HIP_MEMORY_SCOPE_AGENT); *slot = (int)v; }
        __syncthreads();
        const int it = __builtin_amdgcn_readfirstlane(*slot);
        if (it >= 1024) break;
        const int qb = 7 - (it >> 7), bh = it & 127, b = bh >> 4, h = bh & 15;
        fox_unit(lds, b, h, qb, proj, proj + mats, proj + 2 * mats, proj + 3 * mats, AO, cloc, ctot, qn, kn);
    }
}

constexpr int DA_OG = 0, DA_LSE2 = 2 * 256 * 128, DA_LSE = 3 * 256 * 128, DA_VST = DA_LSE + 3 * 256 * 4, DA_VROW = 144, DA_VBYTES = 32 * DA_VROW;
static_assert(DA_VST + 8 * DA_VBYTES <= 140000, "dswa LDS map");

DI void dsw_group(const bf16_t* Qh, const bf16_t* Kh, const bf16_t* Vh, int R, int cls, int e0w, int tq, int jmin, unsigned char* st, const unsigned char* kfb, int trb,
                  int lrow, int lch, int r32, int hi, f32x16& o0, f32x16& o1, float& mrow, float& lsum) {
    bf16x8 qr[4];
    const int sh = R == 1 ? 9 : (R == 4 ? 7 : 5);
#define DSW_ROW(el_) ((((el_) >> sh) << 9) + (cls << sh) + ((el_) & ((1 << sh) - 1)))
    { const bf16_t* qp = Qh + (size_t)DSW_ROW(e0w + r32) * DM + 8 * hi;
#pragma unroll
      for (int s = 0; s < 4; ++s) qr[s] = *(const bf16x8*)(qp + 16 * s); }
    o0 = f32x16{}; o1 = f32x16{}; mrow = -1e30f; lsum = 0.f;
    u32x4 kn[4], vn[4];
#define DSW_LOAD(jj_, kd, vd) do { _Pragma("unroll") for (int it_ = 0; it_ < 4; ++it_) { const size_t o_ = (size_t)DSW_ROW(e0w - 128 + 32 * (jj_) + 8 * it_ + lrow) * DM + 8 * lch; \
        kd[it_] = *(const u32x4*)(Kh + o_); vd[it_] = *(const u32x4*)(Vh + o_); } } while (0)
#define DSW_STAGE(src) do { _Pragma("unroll") for (int it_ = 0; it_ < 4; ++it_) *(u32x4*)(st + (8 * it_ + lrow) * DA_VROW + 16 * lch) = src[it_]; } while (0)
    DSW_LOAD(jmin, kn, vn);
    const int ql = r32 - 4 * hi;
#pragma unroll 1
    for (int jj = jmin; jj < 5; ++jj) {
        u32x4 kc[4], vc[4];
#pragma unroll
        for (int s = 0; s < 4; ++s) { kc[s] = kn[s]; vc[s] = vn[s]; }
        if (jj + 1 < 5) DSW_LOAD(jj + 1, kn, vn);
        DSW_STAGE(kc);
        f32x16 p = {};
        { bf16x8 kf_[4];
#pragma unroll
          for (int s = 0; s < 4; ++s) kf_[s] = *(const bf16x8*)(kfb + 32 * s);
          __builtin_amdgcn_s_setprio(1);
#pragma unroll
          for (int s = 0; s < 4; ++s) p = MFMA32(kf_[s], qr[s], p);
          __builtin_amdgcn_s_setprio(0); }
        DSW_STAGE(vc);
        if (jj == 0) {
            asm volatile("" ::: "memory");
#pragma unroll
            for (int i = 0; i < 16; ++i) p[i] = ((i & 3) + 8 * (i >> 2)) >= ql ? p[i] : -INFINITY;
        } else if (jj == 4) {
            asm volatile("" ::: "memory");
#pragma unroll
            for (int i = 0; i < 16; ++i) p[i] = ((i & 3) + 8 * (i >> 2)) <= ql ? p[i] : -INFINITY;
        }
        float ma = mrow, mb = max2f(p[0], p[1]);
#pragma unroll
        for (int i = 2; i < 16; i += 4) { ma = max3f(ma, p[i], p[i + 1]); if (i + 2 < 16) mb = max3f(mb, p[i + 2], p[i + 3]); }
        float mx = max2f(ma, mb);
        mx = xhalf_max(mx);
        const float alpha = fexp2(mrow - mx); mrow = mx;
        const float rs = exp_sum16(p, mx);
        lsum = lsum * alpha + rs;
        const bf16x8 pf0 = pack8(p[0], p[1], p[2], p[3], p[4], p[5], p[6], p[7]), pf1 = pack8(p[8], p[9], p[10], p[11], p[12], p[13], p[14], p[15]);
        if (__builtin_amdgcn_ballot_w64(alpha != 1.f) != 0ull) { scale16(o0, alpha); scale16(o1, alpha); }
        const unsigned char* vb = st + trb;
#pragma unroll
        for (int ks = 0; ks < 2; ++ks) {
            const bf16x8 pf = ks == 0 ? pf0 : pf1;
            const s16x4 a0l = vtr(vb + ks * 16 * DA_VROW), a0h = vtr(vb + (ks * 16 + 8) * DA_VROW);
            const s16x4 a1l = vtr(vb + ks * 16 * DA_VROW + 64), a1h = vtr(vb + (ks * 16 + 8) * DA_VROW + 64);
            const bf16x8 va0 = __builtin_shufflevector(a0l, a0h, 0, 1, 2, 3, 4, 5, 6, 7), va1 = __builtin_shufflevector(a1l, a1h, 0, 1, 2, 3, 4, 5, 6, 7);
            __builtin_amdgcn_s_setprio(1); o0 = MFMA32(va0, pf, o0); o1 = MFMA32(va1, pf, o1); __builtin_amdgcn_s_setprio(0);
        }
    }
#undef DSW_LOAD
#undef DSW_STAGE
#undef DSW_ROW
    lsum += __shfl_xor(lsum, 32);
}

DI void dsw_unit(unsigned char* lds, int bl, int sb, int h, const bf16_t* proj, size_t mats, bf16_t* AO) {
    const int tid = mk_tid(), lane = tid & 63, wid = __builtin_amdgcn_readfirstlane(tid >> 6), r32 = lane & 31, hi = lane >> 5;
    const size_t rowbase = (size_t)bl * SEQ; const int T0s = sb * 512;
    unsigned char* st = lds + DA_VST + wid * DA_VBYTES;
    const int lrow = lane >> 3, lch = lane & 7;
    const int trb = ((lane >> 4) & 1) * 32 + (lane & 3) * 8 + (4 * hi + ((lane & 15) >> 2)) * DA_VROW;
    const unsigned char* kfb = st + r32 * DA_VROW + 16 * hi;
    f32x16 o0, o1; float mrow, lsum;
#pragma unroll 1
    for (int qt = 0; qt < 2; ++qt) {
        const int cls = 2 * wid + qt, e0w = T0s >> 4, tq = T0s + 16 * r32 + cls;
        int jmin = 4 - (e0w >> 5); jmin = jmin < 0 ? 0 : jmin;
        const size_t hb = rowbase * DM + h * HD;
        dsw_group(proj + 2 * mats + hb, proj + 5 * mats + hb, proj + 8 * mats + hb, 16, cls, e0w, tq, jmin, st, kfb, trb, lrow, lch, r32, hi, o0, o1, mrow, lsum);
        const float inv = 1.f / lsum;
        bf16_t* orow = AO + (rowbase + tq) * DM + h * HD + 4 * hi;
#pragma unroll
        for (int mt = 0; mt < 2; ++mt)
#pragma unroll
            for (int q = 0; q < 4; ++q) { const f32x16& o = mt ? o1 : o0;
                u32x2 w; w.x = cvtpk(o[4 * q] * inv, o[4 * q + 1] * inv); w.y = cvtpk(o[4 * q + 2] * inv, o[4 * q + 3] * inv);
                *(u32x2*)(orow + 32 * mt + 8 * q) = w; }
        if (hi == 0) ((float*)(lds + DA_LSE2))[tq - T0s] = mrow + __log2f(lsum);
    }
    __syncthreads();
#pragma unroll 1
    for (int half = 0; half < 2; ++half) {
        const int T0 = T0s + 256 * half;
        const size_t coff = (rowbase + T0 + (tid >> 1)) * DM + h * HD + 32 * (tid & 1);
        u32x4 gt4[4];
#pragma unroll
        for (int c = 0; c < 4; ++c) gt4[c] = *(const u32x4*)(proj + 9 * mats + coff + 8 * c);
#pragma unroll 1
        for (int g = 0; g < 2; ++g) {
            const size_t hb = rowbase * DM + h * HD;
            int e0w, cls, tq, R;
            if (g == 0) { R = 1; cls = 0;       e0w = T0 + 32 * wid;                 tq = e0w + r32; }
            else        { R = 4; cls = wid & 3; e0w = (T0 >> 2) + 32 * (wid >> 2);   tq = 4 * (e0w + r32) + cls; }
            int jmin = 4 - (e0w >> 5); jmin = jmin < 0 ? 0 : jmin;
            dsw_group(proj + (size_t)g * mats + hb, proj + (size_t)(3 + g) * mats + hb, proj + (size_t)(6 + g) * mats + hb, R, cls, e0w, tq, jmin, st, kfb, trb, lrow, lch, r32, hi, o0, o1, mrow, lsum);
            const float inv = 1.f / lsum;
            const int tl = tq - T0;
            unsigned char* og = lds + DA_OG + g * 32768 + tl * 128 + 8 * hi;
#pragma unroll
            for (int mt = 0; mt < 2; ++mt)
#pragma unroll
                for (int q = 0; q < 4; ++q) { const f32x16& o = mt ? o1 : o0;
                    u32x2 w; w.x = cvtpk(o[4 * q] * inv, o[4 * q + 1] * inv); w.y = cvtpk(o[4 * q + 2] * inv, o[4 * q + 3] * inv);
                    *(u32x2*)(og + 64 * mt + 16 * q) = w; }
            if (hi == 0) ((float*)(lds + DA_LSE))[g * 256 + tl] = mrow + __log2f(lsum);
        }
        __syncthreads();
        {
            const int tl = tid >> 1, dh = tid & 1;
            const float* lse = (const float*)(lds + DA_LSE);
            const float l0 = lse[tl], l1 = lse[256 + tl], l2 = ((const float*)(lds + DA_LSE2))[256 * half + tl], mx = fmaxf(l0, fmaxf(l1, l2));
            float w0 = fexp2(l0 - mx), w1 = fexp2(l1 - mx), w2 = fexp2(l2 - mx); const float inv = 1.f / (w0 + w1 + w2); w0 *= inv; w1 *= inv; w2 *= inv;
#pragma unroll
            for (int c = 0; c < 4; ++c) {
                const u32x4 a = *(const u32x4*)(lds + DA_OG + tl * 128 + 64 * dh + 16 * c), bq = *(const u32x4*)(lds + DA_OG + 32768 + tl * 128 + 64 * dh + 16 * c),
                            cq = *(const u32x4*)(AO + coff + 8 * c), gt = gt4[c];
                u32x4 w;
#pragma unroll
                for (int e = 0; e < 4; ++e) {
                    const float lo = (w0 * bf_lo(a[e]) + w1 * bf_lo(bq[e]) + w2 * bf_lo(cq[e])) * silu(bf_lo(gt[e]));
                    const float hv = (w0 * bf_hi(a[e]) + w1 * bf_hi(bq[e]) + w2 * bf_hi(cq[e])) * silu(bf_hi(gt[e]));
                    w[e] = cvtpk(lo, hv);
                }
                *(u32x4*)(AO + coff + 8 * c) = w;
            }
        }
        __syncthreads();
    }
}
DI void dsw_attn_phase(unsigned char* lds, const bf16_t* proj, bf16_t* AO_half) {
    const size_t mats = (size_t)(MTOK / 2) * DM;
    for (int u = blockIdx.x; u < 256; u += gridDim.x) dsw_unit(lds, u >> 6, (u >> 4) & 3, u & 15, proj, mats, AO_half);
}

typedef __attribute__((address_space(1))) unsigned gu32;
#define XB_TMO      128
#define XB_XCNT(j)  (256  + 64 * (j))
#define XB_XSUB(j)  (1280 + 64 * (j))
#define XB_XGEN(j)  (2304 + 64 * (j))
#define XB_TOP      3328
#define XB_TOPGEN   3392
#define XCD_BAR_WORDS 3456
#define XB_SPIN_CAP (1u << 18)

__device__ __forceinline__ unsigned xb_ld(unsigned* p)              { return __hip_atomic_load(p, __ATOMIC_RELAXED, __HIP_MEMORY_SCOPE_AGENT); }
__device__ __forceinline__ unsigned xb_add(unsigned* p, unsigned v) { return __hip_atomic_fetch_add(p, v, __ATOMIC_RELAXED, __HIP_MEMORY_SCOPE_AGENT); }
__device__ __forceinline__ unsigned xb_xcc_id() { return (unsigned)__builtin_amdgcn_s_getreg((3 << 11) | 20) & 0xFu; }
#define XB_SPIN(cond, bar) do { unsigned _sp = 0; while (cond) { __builtin_amdgcn_s_sleep(1); \
    if ((++_sp & 255u) == 0u) { if (xb_ld(&(bar)[XB_TMO])) break; if (_sp > XB_SPIN_CAP) { atomicAdd(&(bar)[XB_TMO], 1u); break; } } } } while (0)

struct XcdBarrier {
    unsigned* bar; unsigned x;
    volatile LAS unsigned* st;
};

__device__ __forceinline__ XcdBarrier xcd_barrier_post(unsigned* bar, volatile LAS unsigned* st) {
    XcdBarrier b; b.bar = bar; b.x = xb_xcc_id(); b.st = st;
    if (threadIdx.x == 0) (void)xb_add(&bar[XB_XCNT(b.x)], 1u);
    return b;
}
__device__ __forceinline__ void xcd_barrier_complete(unsigned* bar, unsigned x, unsigned& nloc, unsigned& nx) {
    const unsigned G = gridDim.x * gridDim.y * gridDim.z;
    unsigned sum, cnt, mine, sp = 0u;
    for (;;) {
        sum = 0u; cnt = 0u; mine = 0u;
#pragma unroll
        for (unsigned j = 0; j < 16; ++j) { const unsigned c = xb_ld(&bar[XB_XCNT(j)]); sum += c; cnt += (c > 0u) ? 1u : 0u; mine = (j == x) ? c : mine; }
        if (sum == G) break;
        __builtin_amdgcn_s_sleep(1);
        if ((++sp & 255u) == 0u) { if (xb_ld(&bar[XB_TMO])) break; if (sp > XB_SPIN_CAP) { atomicAdd(&bar[XB_TMO], 1u); break; } }
    }
    nloc = mine > 0u ? mine : 1u; nx = cnt > 0u ? cnt : 1u;
}

__device__ __forceinline__ void xcd_barrier(const XcdBarrier& b) {
    asm volatile("s_waitcnt vmcnt(0)" ::: "memory");
    __syncthreads();
    if (threadIdx.x == 0) {
        unsigned* bar = b.bar;
        __builtin_amdgcn_s_waitcnt(0);
        unsigned nloc = b.st[0], nx = b.st[1];
        if (nloc == 0u) { xcd_barrier_complete(bar, b.x, nloc, nx); b.st[0] = nloc; b.st[1] = nx; }
        const unsigned old = xb_add(&bar[XB_XSUB(b.x)], 1u);
        const unsigned gen = old / nloc;
        if (old + 1u == (gen + 1u) * nloc) {
            __builtin_amdgcn_fence(__ATOMIC_RELEASE, "agent");
            asm volatile("s_waitcnt vmcnt(0)" ::: "memory");
            const unsigned og = xb_add(&bar[XB_TOP], 1u);
            const unsigned tg = og / nx;
            if (og + 1u == (tg + 1u) * nx) xb_add(&bar[XB_TOPGEN], 1u);
            else XB_SPIN(xb_ld(&bar[XB_TOPGEN]) == tg, bar);
            __builtin_amdgcn_fence(__ATOMIC_ACQUIRE, "agent");
            xb_add(&bar[XB_XGEN(b.x)], 1u);
            asm volatile("s_waitcnt vmcnt(0)" ::: "memory");
        } else {
            XB_SPIN(xb_ld(&bar[XB_XGEN(b.x)]) == gen, bar);
            __builtin_amdgcn_fence(__ATOMIC_ACQUIRE, "agent");
            asm volatile("s_waitcnt vmcnt(0)" ::: "memory");
        }
    }
    __syncthreads();
}

__global__ void __launch_bounds__(NTHREADS, 2) fwd_megakernel(Args a) {
    extern __shared__ __attribute__((aligned(16))) unsigned char lds[];
    cg::grid_group grid = cg::this_grid();
    unsigned char* ws = a.ws;
    bf16_t* XB = (bf16_t*)(ws + WS_XB); bf16_t* AO = (bf16_t*)(ws + WS_AO); bf16_t* PROJ = (bf16_t*)(ws + WS_PROJ);
    float* SSQ = (float*)(ws + WS_SSQ); float* ROT = (float*)(ws + WS_ROT); float* CLOC = (float*)(ws + WS_CLOC); float* CTOT = (float*)(ws + WS_CTOT);
    PG8_LAS unsigned char* ldsl = (PG8_LAS unsigned char*)lds;

    volatile LAS unsigned* MISC = (volatile LAS unsigned*)((LAS unsigned char*)lds + LDS_BYTES - 64);
    if (threadIdx.x < 16) MISC[threadIdx.x] = 0u;
    __syncthreads();
    for (int rep = 0; rep < REP_PRO; ++rep) prologue(a, lds);
    if (blockIdx.x == 0) for (int w = threadIdx.x; w < (int)(CTL_ZERO_BYTES / 4); w += NTHREADS) __hip_atomic_store((unsigned*)(ws + WS_CTL) + w, 0u, __ATOMIC_RELAXED, __HIP_MEMORY_SCOPE_AGENT);
    grid.sync();
    XcdBarrier bar = xcd_barrier_post((unsigned*)(ws + WS_CTL), MISC);
#pragma unroll 1
    for (int layer = 0; layer < 4; ++layer) {
        const int j = layer >> 1; const bool dsw = layer & 1;
        const float* xcur = layer == 0 ? a.x : a.out;
        const int nhalf = dsw ? 2 : 1;
#pragma unroll 1
        for (int half = 0; half < nhalf; ++half) {
            if (!dsw) for (int rep = 0; rep < REP_FG; ++rep) fg_step(xcur, (const bf16_t*)(ws + WS_WF) + (size_t)j * 2 * 16 * DM, a.fox_b_f + j * NH, CLOC, CTOT, lds);
            for (int rep = 0; rep < REP_PROJ; ++rep) {
                const int Mg = dsw ? MTOK / 2 : MTOK, Ng = dsw ? 10240 : 4096, row_off = half * (MTOK / 2);
                const bf16_t* Bt = dsw ? (const bf16_t*)(ws + WS_WDSW) + (size_t)j * 10240 * DM : (const bf16_t*)(ws + WS_WFOX) + (size_t)j * 4096 * DM;
                pg8::Gemm g{XB + (size_t)row_off * DM, Bt, Mg, Ng, DM}; pg8::StaticOrder S; S.init(Mg, Ng, (int)gridDim.x, (int)blockIdx.x);
                EpiProj E{PROJ, (size_t)Mg * DM, SSQ, ROT, row_off, dsw ? a.dsw_qn + j * 3 * HD : a.fox_qn + j * HD, dsw ? a.dsw_kn + j * 3 * HD : a.fox_kn + j * HD, dsw ? 3 : 1};
                pg8::gemm_phase<EpiProj, pg8::StaticOrder, true, true>(ldsl, g, S, E);
            }
            xcd_barrier(bar);
            if (!dsw) for (int rep = 0; rep < REP_FOX; ++rep) fox_attn_phase(lds, PROJ, AO, CLOC, CTOT, a.fox_qn + j * HD, a.fox_kn + j * HD, (unsigned*)(ws + WS_CTL) + 3600 + j);
            if (dsw) for (int rep = 0; rep < REP_DSW; ++rep) dsw_attn_phase(lds, PROJ, AO + (size_t)half * (MTOK / 2) * DM);
            xcd_barrier(bar);
        }
        {
            pg8::Gemm g{AO, (const bf16_t*)(ws + WS_WOUT) + (size_t)layer * DM * DM, MTOK, DM, DM}; pg8::StaticOrder S; S.init(MTOK, DM, (int)gridDim.x, (int)blockIdx.x);
            EpiOut E{xcur, a.out, XB, SSQ, layer == 3 ? 1 : 0};
            pg8::gemm_phase<EpiOut, pg8::StaticOrder, true, true>(ldsl, g, S, E);
        }
        if (layer < 3) for (int rep = 0; rep < REP_SYNC; ++rep) xcd_barrier(bar);
    }
}

extern "C" void kernel_launch(void* const* d_in, const int* in_sizes, int n_in, void* d_out, int out_size, void* d_ws, size_t ws_size, hipStream_t stream) {
    static int grid_blocks = 0;
    if (grid_blocks == 0) {
        if (n_in != 12 || in_sizes[0] != MTOK * DM || out_size != MTOK * DM || ws_size < WS_END) {
            fprintf(stderr, "kernel_launch: unexpected shapes (n_in %d, in0 %d, out %d, ws %zu < %zu); nothing launched\n", n_in, n_in > 0 ? in_sizes[0] : -1, out_size, ws_size, (size_t)WS_END); grid_blocks = -1; return; }
        int dev = 0, cus = 0, per_cu = 0;
        hipGetDevice(&dev); hipDeviceGetAttribute(&cus, hipDeviceAttributeMultiprocessorCount, dev);
        if (hipFuncSetAttribute((const void*)fwd_megakernel, hipFuncAttributeMaxDynamicSharedMemorySize, LDS_BYTES) != hipSuccess) { fprintf(stderr, "kernel_launch: hipFuncSetAttribute failed\n"); grid_blocks = -1; return; }
        if (hipOccupancyMaxActiveBlocksPerMultiprocessor(&per_cu, (const void*)fwd_megakernel, NTHREADS, LDS_BYTES) != hipSuccess || per_cu < 1) { fprintf(stderr, "kernel_launch: occupancy query failed (%d)\n", per_cu); grid_blocks = -1; return; }
        grid_blocks = cus * per_cu;
    }
    if (grid_blocks < 0) return;
    Args a{};
    a.x = (const float*)d_in[0]; a.pos = (const int*)d_in[1]; a.norm_g = (const float*)d_in[2]; a.fox_w_in = (const float*)d_in[3]; a.fox_b_f = (const float*)d_in[4];
    a.fox_qn = (const float*)d_in[5]; a.fox_kn = (const float*)d_in[6]; a.fox_w_out = (const float*)d_in[7]; a.dsw_w_in = (const float*)d_in[8]; a.dsw_qn = (const float*)d_in[9];
    a.dsw_kn = (const float*)d_in[10]; a.dsw_w_out = (const float*)d_in[11]; a.out = (float*)d_out; a.ws = (unsigned char*)d_ws;
    void* args[] = {&a};
    hipError_t e = hipLaunchCooperativeKernel((const void*)fwd_megakernel, dim3(grid_blocks), dim3(NTHREADS), args, LDS_BYTES, stream);
    if (e != hipSuccess) fprintf(stderr, "kernel_launch: cooperative launch failed: %s (grid %d)\n", hipGetErrorString(e), grid_blocks);
}
```
